# Optimizing an MI355X kernel written in HIP

```python
import jax, jax.numpy as jnp
from jax import lax
import numpy as np

D_MODEL = 1024
BATCH = 8
SEQ = 2048
DEPTH = 2
DEC_BATCH = 128
DEC_SEQ = 8
PAST_LEN = 16384
PAGE_SIZE = 128

POOL_WINDOWS = (2, 4, 8, 16)
N_POOL_GROUPS = len(POOL_WINDOWS)
D_POOL = D_MODEL // 2
POOL_GROUP = D_POOL // N_POOL_GROUPS
POOL_BUF = max(POOL_WINDOWS) - 1
D_RNN = D_MODEL
N_RNN_BLOCKS = 8
RNN_BLOCK = D_RNN // N_RNN_BLOCKS
RNN_CONV = 4
RG_C = 8.0
N_HEADS = 4
HEAD_DIM = 128
D_Q = N_HEADS * HEAD_DIM
N_MEM = 256
D_MIX = D_POOL + D_RNN + D_Q
N_BRANCH = 3
D_FF = 3 * D_MODEL
FFN_CONV = 3
EPS = 1e-6

kernel_name = "hybrid_pool_rglru_memxattn_decoder_step"


def rmsnorm(x, g):
    xf = x.astype(jnp.float32)
    y = xf * lax.rsqrt(jnp.mean(xf * xf, axis=-1, keepdims=True) + EPS)
    return (y * g.astype(jnp.float32)).astype(x.dtype)


def causal_dwconv(u, buf, w, b):
    k = w.shape[0]
    t = u.shape[1]
    ext = jnp.concatenate([buf.astype(u.dtype), u], axis=1)
    y = b
    for j in range(k):
        y = y + ext[:, j:j + t] * w[j]
    return y, ext[:, -(k - 1):]


def pool_mixer(u, buf, pos0, w_grp, scale):
    B, T, _ = u.shape
    ext = jnp.concatenate([buf.astype(u.dtype), u], axis=1)
    cs = jnp.cumsum(ext.astype(jnp.float32), axis=1)
    cs = jnp.pad(cs, ((0, 0), (1, 0), (0, 0)))
    pos = pos0 + jnp.arange(T, dtype=jnp.int32)
    outs = []
    for g, w in enumerate(POOL_WINDOWS):
        sl = slice(g * POOL_GROUP, (g + 1) * POOL_GROUP)
        win = cs[:, POOL_BUF + 1:POOL_BUF + 1 + T, sl] - cs[:, POOL_BUF + 1 - w:POOL_BUF + 1 - w + T, sl]
        cnt = jnp.minimum(pos + 1, w).astype(jnp.float32)[None, :, None]
        outs.append(win / cnt)
    d = (jnp.concatenate(outs, axis=-1) - u.astype(jnp.float32)).reshape(B, T, N_POOL_GROUPS, POOL_GROUP)
    y = jnp.einsum('btgc,gcd->btgd', d, w_grp.astype(jnp.float32)).reshape(B, T, D_POOL)
    y = y * scale.astype(jnp.float32)
    return y.astype(u.dtype), ext[:, -POOL_BUF:]


def _lin_combine(c1, c2):
    a1, b1 = c1
    a2, b2 = c2
    return a1 * a2, a2 * b1 + b2


def rglru(u, conv_buf, h0, conv_w, conv_b, w_a, b_a, w_x, b_x, lam):
    xc, new_conv = causal_dwconv(u, conv_buf, conv_w, conv_b)
    B, T, _ = xc.shape
    xf = xc.astype(jnp.float32)
    xb = xf.reshape(B, T, N_RNN_BLOCKS, RNN_BLOCK)
    r = jax.nn.sigmoid(jnp.einsum('btnc,ncd->btnd', xb, w_a.astype(jnp.float32)).reshape(B, T, D_RNN) + b_a.astype(jnp.float32))
    i = jax.nn.sigmoid(jnp.einsum('btnc,ncd->btnd', xb, w_x.astype(jnp.float32)).reshape(B, T, D_RNN) + b_x.astype(jnp.float32))
    log_a = -RG_C * r * jax.nn.softplus(-lam.astype(jnp.float32))
    a = jnp.exp(log_a)
    beta = jnp.sqrt(-jnp.expm1(2.0 * log_a))
    bterm = beta * (i * xf)
    bterm = bterm.at[:, 0].add(a[:, 0] * h0.astype(jnp.float32))
    _, h = lax.associative_scan(_lin_combine, (a, bterm), axis=1)
    return h.astype(u.dtype), new_conv, h[:, -1].astype(h0.dtype)


def mem_kv(mem, g_mem, w_k, w_v):
    B = mem.shape[0]
    mn = rmsnorm(mem, g_mem)
    k = (mn @ w_k).reshape(B, N_MEM, N_HEADS, HEAD_DIM)
    v = (mn @ w_v).reshape(B, N_MEM, N_HEADS, HEAD_DIM)
    return k, v


def cross_attn(q, k, v):
    s = jnp.einsum('bthd,bmhd->bhtm', q.astype(jnp.float32), k.astype(jnp.float32)) * (HEAD_DIM ** -0.5)
    p = jax.nn.softmax(s, axis=-1)
    o = jnp.einsum('bhtm,bmhd->bthd', p, v.astype(jnp.float32))
    return o.astype(q.dtype)


def layer(h, m_k, m_v, pool_buf, rnn_buf, rnn_h0, ffn_buf, pos0, lw):
    B, T, _ = h.shape
    xn = rmsnorm(h, lw['g_mix'])
    z = xn @ lw['w_in']
    u_pool = z[..., :D_POOL]
    u_rnn = z[..., D_POOL:D_POOL + D_RNN]
    q = z[..., D_POOL + D_RNN:].reshape(B, T, N_HEADS, HEAD_DIM)
    gates = jax.nn.sigmoid((xn @ lw['w_gate'] + lw['b_gate']).astype(jnp.float32)).reshape(B, T, N_BRANCH, D_MODEL)
    y_pool, new_pool = pool_mixer(u_pool, pool_buf, pos0, lw['pool_w'], lw['pool_scale'])
    y_rnn, new_rnn_buf, new_h = rglru(u_rnn, rnn_buf, rnn_h0, lw['rnn_conv_w'], lw['rnn_conv_b'],
                                      lw['rnn_wa'], lw['rnn_ba'], lw['rnn_wx'], lw['rnn_bx'], lw['rnn_lambda'])
    y_attn = cross_attn(q, m_k, m_v).reshape(B, T, D_Q)
    merged = (gates[:, :, 0] * (y_pool @ lw['w_br_pool']).astype(jnp.float32)
              + gates[:, :, 1] * (y_rnn @ lw['w_br_rnn']).astype(jnp.float32)
              + gates[:, :, 2] * (y_attn @ lw['w_br_attn']).astype(jnp.float32)).astype(h.dtype)
    h = h + merged @ lw['w_out']
    xn2 = rmsnorm(h, lw['g_ffn'])
    gv = xn2 @ lw['w_up']
    g_pre, val = gv[..., :D_FF], gv[..., D_FF:]
    g_conv, new_ffn = causal_dwconv(g_pre, ffn_buf, lw['ffn_conv_w'], lw['ffn_conv_b'])
    h = h + (jax.nn.gelu(g_conv) * val) @ lw['w_down']
    return h, new_pool, new_rnn_buf, new_h, new_ffn


def setup_inputs(seed: int = 0) -> dict:
    key = jax.random.key(seed)
    ks = iter(jax.random.split(key, 40))

    def nrm(shape, scale):
        return jax.random.normal(next(ks), shape, jnp.float32) * scale

    u = jax.random.uniform(next(ks), (DEPTH, D_RNN), jnp.float32, minval=0.9, maxval=0.999)
    a0 = u ** (1.0 / RG_C)
    rnn_lambda = jnp.log(a0) - jnp.log1p(-a0)
    return {
        'x_prompt': nrm((BATCH, SEQ, D_MODEL), 1.0),
        'x_sample': nrm((DEC_BATCH, DEC_SEQ, D_MODEL), 1.0),
        'mem_prompt': nrm((BATCH, N_MEM, D_MODEL), 1.0),
        'cache_mem_k': nrm((DEPTH, DEC_BATCH, N_MEM, N_HEADS, HEAD_DIM), 1.0),
        'cache_mem_v': nrm((DEPTH, DEC_BATCH, N_MEM, N_HEADS, HEAD_DIM), 1.0),
        'state_pool': nrm((DEPTH, DEC_BATCH, POOL_BUF, D_POOL), 1.0),
        'state_rnn_conv': nrm((DEPTH, DEC_BATCH, RNN_CONV - 1, D_RNN), 1.0),
        'state_rnn_h': nrm((DEPTH, DEC_BATCH, D_RNN), 0.5),
        'state_ffn_conv': nrm((DEPTH, DEC_BATCH, FFN_CONV - 1, D_FF), 1.0),
        'g_mix': 1.0 + nrm((DEPTH, D_MODEL), 0.05),
        'w_in': nrm((DEPTH, D_MODEL, D_MIX), D_MODEL ** -0.5),
        'w_gate': nrm((DEPTH, D_MODEL, N_BRANCH * D_MODEL), D_MODEL ** -0.5),
        'b_gate': nrm((DEPTH, N_BRANCH * D_MODEL), 0.01),
        'pool_w': nrm((DEPTH, N_POOL_GROUPS, POOL_GROUP, POOL_GROUP), POOL_GROUP ** -0.5),
        'pool_scale': 1.0 + nrm((DEPTH, D_POOL), 0.1),
        'rnn_conv_w': nrm((DEPTH, RNN_CONV, D_RNN), RNN_CONV ** -0.5),
        'rnn_conv_b': nrm((DEPTH, D_RNN), 0.01),
        'rnn_wa': nrm((DEPTH, N_RNN_BLOCKS, RNN_BLOCK, RNN_BLOCK), RNN_BLOCK ** -0.5),
        'rnn_ba': nrm((DEPTH, D_RNN), 0.01),
        'rnn_wx': nrm((DEPTH, N_RNN_BLOCKS, RNN_BLOCK, RNN_BLOCK), RNN_BLOCK ** -0.5),
        'rnn_bx': nrm((DEPTH, D_RNN), 0.01),
        'rnn_lambda': rnn_lambda,
        'g_mem': 1.0 + nrm((DEPTH, D_MODEL), 0.05),
        'w_k': nrm((DEPTH, D_MODEL, D_Q), D_MODEL ** -0.5),
        'w_v': nrm((DEPTH, D_MODEL, D_Q), D_MODEL ** -0.5),
        'w_br_pool': nrm((DEPTH, D_POOL, D_MODEL), D_POOL ** -0.5),
        'w_br_rnn': nrm((DEPTH, D_RNN, D_MODEL), D_RNN ** -0.5),
        'w_br_attn': nrm((DEPTH, D_Q, D_MODEL), D_Q ** -0.5),
        'w_out': nrm((DEPTH, D_MODEL, D_MODEL), D_MODEL ** -0.5),
        'g_ffn': 1.0 + nrm((DEPTH, D_MODEL), 0.05),
        'w_up': nrm((DEPTH, D_MODEL, 2 * D_FF), D_MODEL ** -0.5),
        'ffn_conv_w': nrm((DEPTH, FFN_CONV, D_FF), FFN_CONV ** -0.5),
        'ffn_conv_b': nrm((DEPTH, D_FF), 0.01),
        'w_down': nrm((DEPTH, D_FF, D_MODEL), D_FF ** -0.5),
        'g_final': 1.0 + nrm((D_MODEL,), 0.05),
    }


def reference(x_prompt, x_sample, mem_prompt, cache_mem_k, cache_mem_v, state_pool, state_rnn_conv,
              state_rnn_h, state_ffn_conv, g_mix, w_in, w_gate, b_gate, pool_w, pool_scale,
              rnn_conv_w, rnn_conv_b, rnn_wa, rnn_ba, rnn_wx, rnn_bx, rnn_lambda, g_mem, w_k, w_v,
              w_br_pool, w_br_rnn, w_br_attn, w_out, g_ffn, w_up, ffn_conv_w, ffn_conv_b, w_down, g_final):
    Bp = x_prompt.shape[0]
    hp = x_prompt
    hs = x_sample
    p_pool, p_rconv, p_rh, p_fconv, p_mk, p_mv = [], [], [], [], [], []
    s_pool, s_rconv, s_rh, s_fconv = [], [], [], []
    for l in range(DEPTH):
        lw = {
            'g_mix': g_mix[l], 'w_in': w_in[l], 'w_gate': w_gate[l], 'b_gate': b_gate[l],
            'pool_w': pool_w[l], 'pool_scale': pool_scale[l],
            'rnn_conv_w': rnn_conv_w[l], 'rnn_conv_b': rnn_conv_b[l], 'rnn_wa': rnn_wa[l], 'rnn_ba': rnn_ba[l],
            'rnn_wx': rnn_wx[l], 'rnn_bx': rnn_bx[l], 'rnn_lambda': rnn_lambda[l],
            'w_br_pool': w_br_pool[l], 'w_br_rnn': w_br_rnn[l], 'w_br_attn': w_br_attn[l], 'w_out': w_out[l],
            'g_ffn': g_ffn[l], 'w_up': w_up[l], 'ffn_conv_w': ffn_conv_w[l], 'ffn_conv_b': ffn_conv_b[l],
            'w_down': w_down[l],
        }
        mk, mv = mem_kv(mem_prompt, g_mem[l], w_k[l], w_v[l])
        hp, npool, nrc, nrh, nfc = layer(
            hp, mk, mv,
            jnp.zeros((Bp, POOL_BUF, D_POOL), x_prompt.dtype),
            jnp.zeros((Bp, RNN_CONV - 1, D_RNN), x_prompt.dtype),
            jnp.zeros((Bp, D_RNN), state_rnn_h.dtype),
            jnp.zeros((Bp, FFN_CONV - 1, D_FF), x_prompt.dtype),
            0, lw)
        p_pool.append(npool); p_rconv.append(nrc); p_rh.append(nrh); p_fconv.append(nfc)
        p_mk.append(mk); p_mv.append(mv)
        hs, spool, src, srh, sfc = layer(
            hs, cache_mem_k[l], cache_mem_v[l], state_pool[l], state_rnn_conv[l], state_rnn_h[l],
            state_ffn_conv[l], PAST_LEN, lw)
        s_pool.append(spool); s_rconv.append(src); s_rh.append(srh); s_fconv.append(sfc)
    y_prompt = rmsnorm(hp, g_final)
    y_sample = rmsnorm(hs, g_final)
    return (y_prompt, y_sample,
            jnp.stack(p_pool), jnp.stack(p_rconv), jnp.stack(p_rh), jnp.stack(p_fconv),
            jnp.stack(p_mk), jnp.stack(p_mv),
            jnp.stack(s_pool), jnp.stack(s_rconv), jnp.stack(s_rh), jnp.stack(s_fconv))
```

```cpp
#include <hip/hip_runtime.h>
#include <cstdio>
#include <cstdint>

#define GAS __attribute__((address_space(1)))
#define LAS __attribute__((address_space(3)))
#define CAS __attribute__((address_space(4)))
typedef unsigned short bf16_t;
typedef short bf16x8 __attribute__((ext_vector_type(8)));
typedef float f32x4 __attribute__((ext_vector_type(4)));
typedef float f32x2 __attribute__((ext_vector_type(2)));
typedef unsigned u32x4 __attribute__((ext_vector_type(4)));
typedef unsigned u32x2 __attribute__((ext_vector_type(2)));
#define RLX_AGENT __ATOMIC_RELAXED, __HIP_MEMORY_SCOPE_AGENT
#define LDS_WAIT() asm volatile("s_waitcnt lgkmcnt(0)" ::: "memory")
#define VM_WAIT() asm volatile("s_waitcnt vmcnt(0)" ::: "memory")

namespace pg8 {
constexpr int BM = 256, BK = 64, HALF = 128, HTB = HALF * BK * 2  , STAGE_BYTES = 8 * HTB, NXCD = 8, WGM = 8;

__host__ __device__ __forceinline__ int lds_byte(int r, int c) { const int st = (r >> 4) * 2 + (c >> 5), rr = r & 15, cc = c & 31, ob = rr * 64 + cc * 2; return st * 1024 + (ob ^ (((ob >> 9) & 1) << 5)); }
__host__ __device__ __forceinline__ void stage_rc(int b, int& R, int& C) { const int st = b / 1024, sb = b % 1024, swz = sb ^ (((sb >> 9) & 1) << 5); R = (st >> 1) * 16 + swz / 64; C = (st & 1) * 32 + (swz % 64) / 2; }
__host__ __device__ __forceinline__ int perm32(int rho) { const int n = rho >> 4, i = rho & 15; return 8 * (i >> 2) + 4 * n + (i & 3); }

struct Unit { int pm, pn; };
struct Gemm { const GAS bf16_t* A; const GAS bf16_t* Bt; int lda, ldb, nt, a_pn; };

struct StaticOrder {
    int nM, nN, nwg, G, c;
    __host__ __device__ void init(int nM_, int nN_, int G_, int c_) { nM = nM_; nN = nN_; nwg = nM * nN; G = G_; c = c_; }
    __host__ __device__ bool next(int i, Unit& u) const {
        const long L = (long)i * G + c; if (L >= nwg) return false;
        int wgid = (int)L; { const int q = nwg / NXCD, r = nwg % NXCD, xcd = wgid % NXCD, off = wgid / NXCD; wgid = (xcd < r ? xcd * (q + 1) : r * (q + 1) + (xcd - r) * q) + off; }
        const int nig = WGM * nN, gid = wgid / nig, fm = gid * WGM, gsz = (nM - fm) < WGM ? (nM - fm) : WGM;
        u.pm = fm + ((wgid % nig) % gsz); u.pn = (wgid % nig) / gsz; return true;
    }
};

__device__ __forceinline__ int fresh_lane() { int l; asm volatile("v_mbcnt_lo_u32_b32 %0, -1, 0\n\tv_mbcnt_hi_u32_b32 %0, -1, %0" : "=v"(l)); return l; }
__device__ __forceinline__ unsigned cvt_pk_bf16(float lo, float hi) { unsigned r; asm volatile("v_cvt_pk_bf16_f32 %0, %1, %2" : "=v"(r) : "v"(lo), "v"(hi)); return r; }

template <class Epi, class Sched, bool ALIGN_EPI = false>
__device__ __forceinline__ void gemm_phase(LAS unsigned char* lds, const int wid, const Gemm g, const Sched& S, const Epi& E) {
    const int lane = fresh_lane(), tid = wid * 64 + lane, wr = wid >> 2, wc = wid & 3, fr = lane & 15, fq = lane >> 4;
    const int nt = g.nt;
    unsigned voffA[2], voffB[2];
#pragma unroll
    for (int i = 0; i < 2; ++i) { int R, C; stage_rc(tid * 16 + i * 8192, R, C); const int Rb = Epi::PERM ? ((R & ~31) + perm32(R & 31)) : R;
        voffA[i] = (unsigned)(R * g.lda + C) * 2u; voffB[i] = (unsigned)(Rb * g.ldb + C) * 2u; }
    const size_t kstep = (size_t)(BK * 2);
    const size_t hstepA = (size_t)HALF * g.lda * 2, hstepB = (size_t)HALF * g.ldb * 2;
    const size_t tstepA = 2 * hstepA, tstepB = 2 * hstepB;
    const size_t apn = (size_t)g.a_pn * 2;
    const unsigned ldsw = (unsigned)wid * 1024u;
    const int aoff = lds_byte(wr * 64 + fr, fq * 8), boff = lds_byte(wc * 32 + fr, fq * 8);
#define PG8_SA(b, h) (((b) * 2 + (h)) * HTB)
#define PG8_SB(b, h) ((4 + (b) * 2 + (h)) * HTB)
#define PG8_STAGE(bufoff, gbase, voff) do { const GAS char* gb_ = (gbase); asm volatile("" : "+s"(gb_));   \
        _Pragma("unroll") for (int _i = 0; _i < 2; ++_i) \
        __builtin_amdgcn_global_load_lds((const GAS unsigned*)(gb_ + (voff)[_i]), (LAS unsigned*)(lds + (bufoff) + ldsw + _i * 8192), 16, 0, 0); } while (0)
#define PG8_LDA(dst, b, h) do { _Pragma("unroll") for (int m = 0; m < 4; ++m) _Pragma("unroll") for (int k = 0; k < 2; ++k) dst[m][k] = *(const LAS bf16x8*)(lds + PG8_SA(b, h) + aoff + m * 2048 + k * 1024); } while (0)
#define PG8_LDB(dst, b, h) do { _Pragma("unroll") for (int n = 0; n < 2; ++n) _Pragma("unroll") for (int k = 0; k < 2; ++k) dst[n][k] = *(const LAS bf16x8*)(lds + PG8_SB(b, h) + boff + n * 2048 + k * 1024); } while (0)
#define PG8_MMA(ai, bj, At, Bt) do { __builtin_amdgcn_s_setprio(1); _Pragma("unroll") for (int m = 0; m < 4; ++m) _Pragma("unroll") for (int n = 0; n < 2; ++n) _Pragma("unroll") for (int k = 0; k < 2; ++k) \
        acc[ai][bj][m][n] = __builtin_amdgcn_mfma_f32_16x16x32_bf16(Bt[n][k], At[m][k], acc[ai][bj][m][n], 0, 0, 0); __builtin_amdgcn_s_setprio(0); } while (0)
#define PG8_WAIT_V(n) asm volatile("s_waitcnt vmcnt(" #n ")" ::: "memory")
#define PG8_WAIT_L(n) asm volatile("s_waitcnt lgkmcnt(" #n ")" ::: "memory")
#define PG8_BAR __builtin_amdgcn_s_barrier()
#define PG8_SCHED __builtin_amdgcn_sched_barrier(0)
    Unit cur, nxt; int ui = 0;
    if (!S.next(0, cur)) return;
    f32x4 acc[2][2][4][2];
#pragma unroll
    for (int a = 0; a < 2; ++a)
#pragma unroll
        for (int b = 0; b < 2; ++b)
#pragma unroll
            for (int m = 0; m < 4; ++m)
#pragma unroll
                for (int n = 0; n < 2; ++n) acc[a][b][m][n] = (f32x4){0.f, 0.f, 0.f, 0.f};
    bf16x8 At[4][2], B0[2][2], B1[2][2];
    const GAS char* cA = (const GAS char*)g.A + (size_t)cur.pm * tstepA + (size_t)cur.pn * apn; const GAS char* cB = (const GAS char*)g.Bt + (size_t)cur.pn * tstepB;
    PG8_STAGE(PG8_SB(0, 0), cB, voffB); PG8_STAGE(PG8_SB(0, 1), cB + hstepB, voffB); PG8_STAGE(PG8_SA(0, 0), cA, voffA); PG8_STAGE(PG8_SA(0, 1), cA + hstepA, voffA);
    if (wr == 1) PG8_BAR;
    PG8_WAIT_V(2); PG8_BAR;
    PG8_STAGE(PG8_SB(1, 0), cB + kstep, voffB); PG8_STAGE(PG8_SA(1, 0), cA + kstep, voffA); PG8_STAGE(PG8_SB(1, 1), cB + hstepB + kstep, voffB);
    PG8_WAIT_V(6); PG8_BAR;
    for (;;) {
        const bool has_next = S.next(ui + 1, nxt);
        const GAS char* nA = has_next ? (const GAS char*)g.A + (size_t)nxt.pm * tstepA + (size_t)nxt.pn * apn : cA; const GAS char* nB = has_next ? (const GAS char*)g.Bt + (size_t)nxt.pn * tstepB : cB;
        for (int t = 0; t < nt; t += 2) {
            const bool last = (t == nt - 2);
            const GAS char* a1 = cA + (size_t)(t + 1) * kstep;
            const GAS char* a2 = last ? nA : cA + (size_t)(t + 2) * kstep; const GAS char* b2 = last ? nB : cB + (size_t)(t + 2) * kstep;
            const GAS char* a3 = a2 + kstep; const GAS char* b3 = b2 + kstep;
            PG8_LDB(B0, 0, 0); PG8_LDB(B1, 0, 1); PG8_SCHED; PG8_LDA(At, 0, 0); PG8_STAGE(PG8_SA(1, 1), a1 + hstepA, voffA);
            PG8_WAIT_V(8); PG8_WAIT_L(0); PG8_BAR; PG8_MMA(0, 0, At, B0); PG8_MMA(0, 1, At, B1); PG8_BAR; PG8_SCHED;
            PG8_LDA(At, 0, 1); PG8_STAGE(PG8_SB(0, 0), b2, voffB); PG8_STAGE(PG8_SB(0, 1), b2 + hstepB, voffB); PG8_STAGE(PG8_SA(0, 0), a2, voffA);
            PG8_WAIT_V(8); PG8_WAIT_L(0); PG8_BAR; PG8_MMA(1, 0, At, B0); PG8_MMA(1, 1, At, B1); PG8_BAR; PG8_SCHED;
            PG8_LDB(B0, 1, 0); PG8_LDB(B1, 1, 1); PG8_SCHED; PG8_LDA(At, 1, 0); PG8_STAGE(PG8_SA(0, 1), a2 + hstepA, voffA);
            PG8_WAIT_V(8); PG8_WAIT_L(0); PG8_BAR; PG8_MMA(0, 0, At, B0); PG8_MMA(0, 1, At, B1); PG8_BAR; PG8_SCHED;
            PG8_LDA(At, 1, 1); PG8_STAGE(PG8_SB(1, 0), b3, voffB); PG8_STAGE(PG8_SB(1, 1), b3 + hstepB, voffB); PG8_STAGE(PG8_SA(1, 0), a3, voffA);
            PG8_WAIT_V(8); PG8_WAIT_L(0); PG8_BAR; PG8_MMA(1, 0, At, B0); PG8_MMA(1, 1, At, B1); PG8_BAR; PG8_SCHED;
        }
        if constexpr (ALIGN_EPI) { if (wr == 0) PG8_BAR; }
        { const int l2 = fresh_lane(); E(acc, cur, wr, wc, l2 & 15, l2 >> 4); }
        if (!has_next) break;
#pragma unroll
        for (int a = 0; a < 2; ++a)
#pragma unroll
            for (int b = 0; b < 2; ++b)
#pragma unroll
                for (int m = 0; m < 4; ++m)
#pragma unroll
                    for (int n = 0; n < 2; ++n) acc[a][b][m][n] = (f32x4){0.f, 0.f, 0.f, 0.f};
        cur = nxt; cA = nA; cB = nB; ++ui;
        if constexpr (ALIGN_EPI) { if (wr == 1) PG8_BAR; }
    }
    PG8_WAIT_V(0);
    if constexpr (!ALIGN_EPI) { if (wr == 0) PG8_BAR; }
    PG8_BAR;
#undef PG8_SA
#undef PG8_SB
#undef PG8_STAGE
#undef PG8_LDA
#undef PG8_LDB
#undef PG8_MMA
#undef PG8_WAIT_V
#undef PG8_WAIT_L
#undef PG8_BAR
#undef PG8_SCHED
}
}
#define XB_TMO      128
#define XB_XCNT(j)  (256  + 64 * (j))
#define XB_XSUB(j)  (1280 + 64 * (j))
#define XB_XGEN(j)  (2304 + 64 * (j))
#define XB_TOP      3328
#define XB_TOPGEN   3392
#define XCD_BAR_WORDS 3456
#define XB_SPIN_CAP (1u << 18)

__device__ __forceinline__ unsigned xb_ld(unsigned* p)              { return __hip_atomic_load(p, __ATOMIC_RELAXED, __HIP_MEMORY_SCOPE_AGENT); }
__device__ __forceinline__ unsigned xb_add(unsigned* p, unsigned v) { return __hip_atomic_fetch_add(p, v, __ATOMIC_RELAXED, __HIP_MEMORY_SCOPE_AGENT); }
__device__ __forceinline__ unsigned xb_xcc_id() { return (unsigned)__builtin_amdgcn_s_getreg((3 << 11) | 20) & 0xFu; }
#define XB_SPIN(cond, bar) do { unsigned _sp = 0; while (cond) { __builtin_amdgcn_s_sleep(1); \
    if ((++_sp & 255u) == 0u) { if (xb_ld(&(bar)[XB_TMO])) break; if (_sp > XB_SPIN_CAP) { atomicAdd(&(bar)[XB_TMO], 1u); break; } } } } while (0)

struct XcdBarrier {
    unsigned* bar; unsigned x;
    volatile LAS unsigned* st;
};

__device__ __forceinline__ XcdBarrier xcd_barrier_post(unsigned* bar, volatile LAS unsigned* st) {
    XcdBarrier b; b.bar = bar; b.x = xb_xcc_id(); b.st = st;
    if (threadIdx.x == 0) (void)xb_add(&bar[XB_XCNT(b.x)], 1u);
    return b;
}
__device__ __forceinline__ void xcd_barrier_complete(unsigned* bar, unsigned x, unsigned& nloc, unsigned& nx) {
    const unsigned G = gridDim.x * gridDim.y * gridDim.z;
    unsigned sum, cnt, mine, sp = 0u;
    for (;;) {
        sum = 0u; cnt = 0u; mine = 0u;
#pragma unroll
        for (unsigned j = 0; j < 16; ++j) { const unsigned c = xb_ld(&bar[XB_XCNT(j)]); sum += c; cnt += (c > 0u) ? 1u : 0u; mine = (j == x) ? c : mine; }
        if (sum == G) break;
        __builtin_amdgcn_s_sleep(1);
        if ((++sp & 255u) == 0u) { if (xb_ld(&bar[XB_TMO])) break; if (sp > XB_SPIN_CAP) { atomicAdd(&bar[XB_TMO], 1u); break; } }
    }
    nloc = mine > 0u ? mine : 1u; nx = cnt > 0u ? cnt : 1u;
}

__device__ __forceinline__ void xcd_barrier(const XcdBarrier& b, const bool t0) {
    asm volatile("s_waitcnt vmcnt(0)" ::: "memory");
    __syncthreads();
    if (t0) {
        unsigned* bar = b.bar;
        __builtin_amdgcn_s_waitcnt(0);
        unsigned nloc = b.st[0], nx = b.st[1];
        if (nloc == 0u) { xcd_barrier_complete(bar, b.x, nloc, nx); b.st[0] = nloc; b.st[1] = nx; }
        const unsigned old = xb_add(&bar[XB_XSUB(b.x)], 1u);
        const unsigned gen = old / nloc;
        if (old + 1u == (gen + 1u) * nloc) {
            __builtin_amdgcn_fence(__ATOMIC_RELEASE, "agent");
            asm volatile("s_waitcnt vmcnt(0)" ::: "memory");
            const unsigned og = xb_add(&bar[XB_TOP], 1u);
            const unsigned tg = og / nx;
            if (og + 1u == (tg + 1u) * nx) xb_add(&bar[XB_TOPGEN], 1u);
            else XB_SPIN(xb_ld(&bar[XB_TOPGEN]) == tg, bar);
            __builtin_amdgcn_fence(__ATOMIC_ACQUIRE, "agent");
            xb_add(&bar[XB_XGEN(b.x)], 1u);
            asm volatile("s_waitcnt vmcnt(0)" ::: "memory");
        } else {
            XB_SPIN(xb_ld(&bar[XB_XGEN(b.x)]) == gen, bar);
            __builtin_amdgcn_fence(__ATOMIC_ACQUIRE, "agent");
            asm volatile("s_waitcnt vmcnt(0)" ::: "memory");
        }
    }
    __syncthreads();
}

constexpr int DM = 1024, MPR = 16384, MSA = 1024, MT = MPR + MSA;
constexpr int NBP = 8, TP = 2048, NBS = 128, TS = 8, NL = 2;
constexpr int DPOOL = 512, DRNN = 1024, DQ = 512, DMIX = 2048, DFF = 3072, NMEM = 256, NHEAD = 4, HDIM = 128;
constexpr int MEMROWS = NBP * NMEM;
constexpr float EPSN = 1e-6f;
constexpr size_t O_Y = 0, O_PPOOL = 17825792, O_PRC = 17948672, O_PRH = 17997824, O_PFC = 18014208, O_PMK = 18112512, O_PMV = 20209664,
                 O_SPOOL = 22306816, O_SRC = 24272896, O_SRH = 25059328, O_SFC = 25321472, O_END = 26894336;
enum { I_XP = 0, I_XS, I_MEM, I_CK, I_CV, I_SPOOL, I_SRC, I_SRH, I_SFC, I_GMIX, I_WIN, I_WGATE, I_BGATE, I_POOLW, I_POOLS, I_RCW, I_RCB, I_RWA, I_RBA, I_RWX, I_RBX,
       I_LAM, I_GMEM, I_WK, I_WV, I_WBP, I_WBR, I_WBA, I_WOUT, I_GFFN, I_WUP, I_FCW, I_FCB, I_WDOWN, I_GFIN, N_IN };

constexpr size_t MiB = 1u << 20;
constexpr size_t WS_CTL = 0, CTL_ZERO_BYTES = 64 * 1024;
constexpr size_t WS_W1 = 1 * MiB;
constexpr size_t WS_WKV = 21 * MiB;
constexpr size_t WS_WBR = 25 * MiB;
constexpr size_t WS_WOUT = 33 * MiB;
constexpr size_t WS_WUP = 37 * MiB;
constexpr size_t WS_WDOWN = 61 * MiB;
constexpr size_t WS_PBD = 73 * MiB;
constexpr size_t WS_RW = 74 * MiB;
constexpr size_t WS_MEMB = 75 * MiB;
constexpr size_t WS_KVB = 79 * MiB;
constexpr size_t WS_VTB = 83 * MiB;
constexpr size_t WS_SSQM = 87 * MiB;
constexpr size_t WS_SSQ1 = 88 * MiB;
constexpr size_t WS_SSQ2 = 90 * MiB;
constexpr size_t WS_AGG = 92 * MiB;
constexpr size_t WS_H = 96 * MiB;
constexpr size_t WS_HB = 164 * MiB;
constexpr size_t WS_R = 198 * MiB;
constexpr size_t WS_Z = WS_R;
constexpr size_t WS_G = WS_R + 68 * MiB;
constexpr size_t WS_DB = WS_R + 170 * MiB;
constexpr size_t WS_XC = WS_R + 187 * MiB;
constexpr size_t WS_PP = WS_R + 221 * MiB;
constexpr size_t WS_MRG = WS_XC;
constexpr size_t WS_MB = WS_R + 255 * MiB;
constexpr size_t WS_GV = WS_R;
constexpr size_t WS_ACT = WS_R + 204 * MiB;
constexpr size_t WS_END = WS_R + 306 * MiB;
static_assert((size_t)MT * 1024 * 2 == 34 * MiB, "row-buffer size");
constexpr int CW_BAR = 4096;

constexpr int RING_OFF = 0, RING_BYTES = 131072;
constexpr int LDSCTL_OFF = RING_BYTES, MISC_OFF = LDSCTL_OFF + 320;
constexpr int LDS_BYTES = 147456;
constexpr int NWAVES = 8, NTHR = 512;

using pg8::cvt_pk_bf16;
__device__ __forceinline__ float bf_lo(unsigned w) { return __uint_as_float(w << 16); }
__device__ __forceinline__ float bf_hi(unsigned w) { return __uint_as_float(w & 0xffff0000u); }
__device__ __forceinline__ float bf1(bf16_t b) { return __uint_as_float((unsigned)b << 16); }
__device__ __forceinline__ f32x4 unpack4(u32x2 w) { return (f32x4){bf_lo(w.x), bf_hi(w.x), bf_lo(w.y), bf_hi(w.y)}; }
__device__ __forceinline__ u32x2 pack4(f32x4 v) { u32x2 w; w.x = cvt_pk_bf16(v[0], v[1]); w.y = cvt_pk_bf16(v[2], v[3]); return w; }
__device__ __forceinline__ u32x4 pack8(f32x4 a, f32x4 b) { u32x4 w; w.x = cvt_pk_bf16(a[0], a[1]); w.y = cvt_pk_bf16(a[2], a[3]); w.z = cvt_pk_bf16(b[0], b[1]); w.w = cvt_pk_bf16(b[2], b[3]); return w; }
__device__ __forceinline__ float sigmoidf_(float x) { return __builtin_amdgcn_rcpf(1.0f + __expf(-x)); }
__device__ __forceinline__ f32x4 sigmoid4(f32x4 v) { return (f32x4){sigmoidf_(v[0]), sigmoidf_(v[1]), sigmoidf_(v[2]), sigmoidf_(v[3])}; }
__device__ __forceinline__ float wave_sum(float v) {
#pragma unroll
    for (int o = 1; o < 64; o <<= 1) v += __shfl_xor(v, o);
    return v;
}
__device__ __forceinline__ float row_rs(const GAS float* ssq, int row, int fq) {
    const f32x4 p = *(const GAS f32x4*)(ssq + (size_t)row * 16 + 4 * fq);
    float s = (p[0] + p[1]) + (p[2] + p[3]);
    s += __shfl_xor(s, 16); s += __shfl_xor(s, 32);
    return rsqrtf(s * (1.0f / 1024.0f) + EPSN);
}

using pg8::Unit;
typedef f32x4 AccT[2][2][4][2];

struct EpiP1 {
    static constexpr bool PERM = true;
    const GAS float* ssq; GAS bf16_t* Z; GAS bf16_t* G; const GAS float* bgate;
    __device__ __forceinline__ void operator()(AccT& acc, const Unit& u, int wr, int wc, int fr, int fq) const {
        const int row0 = u.pm * 256 + wr * 64 + fr;
        const bool isz = u.pn < 8;
        const int col0 = (isz ? u.pn : u.pn - 8) * 256 + wc * 32 + 8 * fq;
        GAS bf16_t* base = isz ? Z : G; const int ld = isz ? DMIX : 3 * DM;
        f32x4 bv[2][2];
#pragma unroll
        for (int bj = 0; bj < 2; ++bj)
#pragma unroll
            for (int n = 0; n < 2; ++n) bv[bj][n] = isz ? (f32x4){0.f, 0.f, 0.f, 0.f} : *(const GAS f32x4*)(bgate + col0 + bj * 128 + 4 * n);
#pragma unroll
        for (int ai = 0; ai < 2; ++ai)
#pragma unroll
            for (int m = 0; m < 4; ++m) {
                int row = row0 + ai * 128 + m * 16; asm volatile("" : "+v"(row)); const float rs = row_rs(ssq, row, fq);
                GAS bf16_t* rowp = base + (size_t)row * ld + col0;
#pragma unroll
                for (int bj = 0; bj < 2; ++bj) {
                    f32x4 v0 = acc[ai][bj][m][0] * rs + bv[bj][0], v1 = acc[ai][bj][m][1] * rs + bv[bj][1];
                    if (!isz) { v0 = sigmoid4(v0); v1 = sigmoid4(v1); }
                    *(GAS u32x4*)(rowp + bj * 128) = pack8(v0, v1);
                }
            }
    }
};
struct EpiKV {
    static constexpr bool PERM = false;
    const GAS float* ssq; GAS float* out; GAS bf16_t* KVB; GAS bf16_t* VTB;
    __device__ __forceinline__ void operator()(AccT& acc, const Unit& u, int wr, int wc, int fr, int fq) const {
        const int t = u.pn >> 1, l = t >> 1; const bool isv = (t & 1) != 0;
        const int row0 = u.pm * 256 + wr * 64 + fr, colb = (u.pn & 1) * 256 + wc * 32 + 4 * fq;
        GAS float* ob = out + (isv ? O_PMV : O_PMK) + (size_t)l * MEMROWS * 512;
#pragma unroll
        for (int ai = 0; ai < 2; ++ai)
#pragma unroll
            for (int m = 0; m < 4; ++m) {
                int row = row0 + ai * 128 + m * 16; asm volatile("" : "+v"(row)); const float rs = row_rs(ssq, row, fq);
#pragma unroll
                for (int bj = 0; bj < 2; ++bj)
#pragma unroll
                    for (int n = 0; n < 2; ++n) {
                        const int c = colb + bj * 128 + 16 * n; const f32x4 v = acc[ai][bj][m][n] * rs;
                        *(GAS f32x4*)(ob + (size_t)row * 512 + c) = v;
                        if (!isv) *(GAS u32x2*)(KVB + ((size_t)l * MEMROWS + row) * 512 + c) = pack4(v);
                        else { const int b = row >> 8, key = row & 255, h = c >> 7, d = c & 127;
                            GAS bf16_t* p = VTB + ((((size_t)l * NBP + b) * NHEAD + h) * HDIM + d) * NMEM + key; const u32x2 w = pack4(v);
                            p[0] = (bf16_t)(w.x & 0xffffu); p[NMEM] = (bf16_t)(w.x >> 16); p[2 * NMEM] = (bf16_t)(w.y & 0xffffu); p[3 * NMEM] = (bf16_t)(w.y >> 16); }
                    }
            }
    }
};
struct EpiPool {
    static constexpr bool PERM = true;
    GAS bf16_t* Z;
    __device__ __forceinline__ void operator()(AccT& acc, const Unit& u, int wr, int wc, int fr, int fq) const {
        const int row0 = u.pm * 256 + wr * 64 + fr, col0 = u.pn * 256 + wc * 32 + 8 * fq;
#pragma unroll
        for (int ai = 0; ai < 2; ++ai)
#pragma unroll
            for (int m = 0; m < 4; ++m) { int row = row0 + ai * 128 + m * 16; asm volatile("" : "+v"(row)); GAS bf16_t* rowp = Z + (size_t)row * DMIX + col0;
#pragma unroll
                for (int bj = 0; bj < 2; ++bj) *(GAS u32x4*)(rowp + bj * 128) = pack8(acc[ai][bj][m][0], acc[ai][bj][m][1]); }
    }
};
struct EpiRnn {
    static constexpr bool PERM = true;
    const GAS float* ba; const GAS float* bx; const GAS bf16_t* XC; GAS bf16_t* Z; GAS bf16_t* PP;
    __device__ __forceinline__ void operator()(AccT& acc, const Unit& u, int wr, int wc, int fr, int fq) const {
        const int row0 = u.pm * 256 + wr * 64 + fr, ch0 = u.pn * 128 + wc * 32 + 8 * fq;
        f32x4 bav[2], bxv[2];
#pragma unroll
        for (int n = 0; n < 2; ++n) { bav[n] = *(const GAS f32x4*)(ba + ch0 + 4 * n); bxv[n] = *(const GAS f32x4*)(bx + ch0 + 4 * n); }
#pragma unroll
        for (int ai = 0; ai < 2; ++ai)
#pragma unroll
            for (int m = 0; m < 4; ++m) {
                int row = row0 + ai * 128 + m * 16; asm volatile("" : "+v"(row));
                const u32x4 xw = *(const GAS u32x4*)(XC + (size_t)row * DRNN + ch0);
                const f32x4 x0 = unpack4((u32x2){xw.x, xw.y}), x1 = unpack4((u32x2){xw.z, xw.w});
                const f32x4 r0 = sigmoid4(acc[ai][0][m][0] + bav[0]), r1 = sigmoid4(acc[ai][0][m][1] + bav[1]);
                const f32x4 i0 = sigmoid4(acc[ai][1][m][0] + bxv[0]), i1 = sigmoid4(acc[ai][1][m][1] + bxv[1]);
                *(GAS u32x4*)(Z + (size_t)row * DMIX + DPOOL + ch0) = pack8(r0, r1);
                *(GAS u32x4*)(PP + (size_t)row * DRNN + ch0) = pack8(i0 * x0, i1 * x1);
                asm volatile("" ::: "memory");
            }
    }
};
template <int SEG> struct EpiMrg {
    static constexpr bool PERM = false;
    const GAS bf16_t* G; GAS float* MRG; GAS bf16_t* MB;
    __device__ __forceinline__ void operator()(AccT& acc, const Unit& u, int wr, int wc, int fr, int fq) const {
        const int row0 = u.pm * 256 + wr * 64 + fr, col0 = u.pn * 256 + wc * 32 + 4 * fq;
#pragma unroll
        for (int ai = 0; ai < 2; ++ai)
#pragma unroll
            for (int m = 0; m < 4; ++m) {
                int row = row0 + ai * 128 + m * 16; asm volatile("" : "+v"(row));
#pragma unroll
                for (int bj = 0; bj < 2; ++bj)
#pragma unroll
                    for (int n = 0; n < 2; ++n) {
                        const int c = col0 + bj * 128 + 16 * n;
                        const f32x4 g = unpack4(*(const GAS u32x2*)(G + (size_t)row * (3 * DM) + SEG * DM + c));
                        f32x4 v = g * acc[ai][bj][m][n]; GAS float* mp = MRG + (size_t)row * DM + c;
                        if (SEG == 0) *(GAS f32x4*)mp = v;
                        else if (SEG == 1) *(GAS f32x4*)mp = *(const GAS f32x4*)mp + v;
                        else { v = v + *(const GAS f32x4*)mp; *(GAS u32x2*)(MB + (size_t)row * DM + c) = pack4(v); }
                    }
                asm volatile("" ::: "memory");
            }
    }
};
struct EpiRes {
    static constexpr bool PERM = false;
    const GAS float* baseP; const GAS float* baseS; GAS float* H; GAS bf16_t* HB; GAS float* ssq_out;
    __device__ __forceinline__ void operator()(AccT& acc, const Unit& u, int wr, int wc, int fr, int fq) const {
        const int row0 = u.pm * 256 + wr * 64 + fr, col0 = u.pn * 256 + wc * 32 + 4 * fq;
#pragma unroll
        for (int ai = 0; ai < 2; ++ai)
#pragma unroll
            for (int m = 0; m < 4; ++m) {
                int row = row0 + ai * 128 + m * 16; asm volatile("" : "+v"(row));
                const GAS float* bp = (row < MPR) ? baseP + (size_t)row * DM : baseS + (size_t)(row - MPR) * DM;
                float ss = 0.f;
#pragma unroll
                for (int bj = 0; bj < 2; ++bj)
#pragma unroll
                    for (int n = 0; n < 2; ++n) {
                        const int c = col0 + bj * 128 + 16 * n;
                        const f32x4 v = *(const GAS f32x4*)(bp + c) + acc[ai][bj][m][n];
                        *(GAS f32x4*)(H + (size_t)row * DM + c) = v; *(GAS u32x2*)(HB + (size_t)row * DM + c) = pack4(v);
                        ss += (v[0] * v[0] + v[1] * v[1]) + (v[2] * v[2] + v[3] * v[3]);
                    }
                ss += __shfl_xor(ss, 16); ss += __shfl_xor(ss, 32);
                if (fq == 0) ssq_out[(size_t)row * 16 + u.pn * 4 + wc] = ss;
                if (m & 1) asm volatile("" ::: "memory");
            }
    }
};
struct EpiUp {
    static constexpr bool PERM = true;
    const GAS float* ssq; GAS bf16_t* GV;
    __device__ __forceinline__ void operator()(AccT& acc, const Unit& u, int wr, int wc, int fr, int fq) const {
        const int row0 = u.pm * 256 + wr * 64 + fr, col0 = u.pn * 256 + wc * 32 + 8 * fq;
#pragma unroll
        for (int ai = 0; ai < 2; ++ai)
#pragma unroll
            for (int m = 0; m < 4; ++m) {
                int row = row0 + ai * 128 + m * 16; asm volatile("" : "+v"(row)); const float rs = row_rs(ssq, row, fq);
                GAS bf16_t* rowp = GV + (size_t)row * (2 * DFF) + col0;
#pragma unroll
                for (int bj = 0; bj < 2; ++bj) *(GAS u32x4*)(rowp + bj * 128) = pack8(acc[ai][bj][m][0] * rs, acc[ai][bj][m][1] * rs);
            }
    }
};

struct Args { const GAS float* in[N_IN]; GAS float* out; GAS unsigned char* ws; int ph_lo, ph_hi; };
struct Ctx {
    LAS unsigned char* lds; int tid, lane, wave, G, bid;
    const GAS float* const CAS* in; GAS float* out; GAS unsigned char* ws;
};
#define WSP(T, off) ((GAS T*)(C.ws + (off)))
__device__ __forceinline__ int opq(int i) { asm volatile("" : "+s"(i)); return i; }

__device__ __forceinline__ void tr_item(const GAS float* W, int ldw, const GAS float* kscale, GAS bf16_t* WT, int ldk, int item, int nblk, LAS float* scr, int lane) {
    const int kb = item / nblk, nb = item % nblk, k0 = 64 * kb, n0 = 32 * nb;
#pragma unroll 8
    for (int i = 0; i < 32; ++i) { const int kk = 2 * i + (lane >> 5); float w = W[(size_t)(k0 + kk) * ldw + n0 + (lane & 31)]; if (kscale) w *= kscale[k0 + kk]; scr[kk * 33 + (lane & 31)] = w; }
    LDS_WAIT(); asm volatile("" ::: "memory");
    const int c = lane & 7;
#pragma unroll
    for (int j = 0; j < 4; ++j) { const int n = (lane >> 3) + 8 * j; const LAS float* s = scr + (8 * c) * 33 + n;
        u32x4 o; o.x = cvt_pk_bf16(s[0 * 33], s[1 * 33]); o.y = cvt_pk_bf16(s[2 * 33], s[3 * 33]); o.z = cvt_pk_bf16(s[4 * 33], s[5 * 33]); o.w = cvt_pk_bf16(s[6 * 33], s[7 * 33]);
        *(GAS u32x4*)(WT + (size_t)(n0 + n) * ldk + k0 + 8 * c) = o; }
    LDS_WAIT(); asm volatile("" ::: "memory");
}
__device__ __forceinline__ void row_to_bf16_ssq(const GAS float* xrow, GAS bf16_t* orow, GAS float* ssq16, int lane) {
    const GAS f32x4* xr = (const GAS f32x4*)xrow + lane;
    f32x4 v[4]; float s = 0.f;
#pragma unroll
    for (int j = 0; j < 4; ++j) { v[j] = xr[64 * j]; s += (v[j][0] * v[j][0] + v[j][1] * v[j][1]) + (v[j][2] * v[j][2] + v[j][3] * v[j][3]); }
    s = wave_sum(s);
    GAS u32x2* o8 = (GAS u32x2*)orow + lane;
#pragma unroll
    for (int j = 0; j < 4; ++j) o8[64 * j] = pack4(v[j]);
    if (lane < 16) ssq16[lane] = (lane == 0) ? s : 0.f;
}
__device__ __forceinline__ void phase_prologue(const Ctx& C) {
    LAS float* scr = (LAS float*)(C.lds + RING_OFF + C.wave * 16384);
    const int gw = C.bid * NWAVES + C.wave, NGW = C.G * NWAVES;
    constexpr int PER_L = 9216;
    for (int it = gw; it < 2 * PER_L; it += NGW) {
        const int l = it / PER_L; int r = it % PER_L;
        const GAS float* W; const GAS float* ks = nullptr; GAS bf16_t* dst; int N, ldk;
        if (r < 1024)      { W = C.in[opq(I_WIN)] + (size_t)l * DM * DMIX; N = DMIX; ks = C.in[opq(I_GMIX)] + l * DM; dst = WSP(bf16_t, WS_W1) + (size_t)l * 5120 * DM; ldk = DM; }
        else if (r < 2560) { r -= 1024; W = C.in[opq(I_WGATE)] + (size_t)l * DM * 3 * DM; N = 3 * DM; ks = C.in[opq(I_GMIX)] + l * DM; dst = WSP(bf16_t, WS_W1) + ((size_t)l * 5120 + 2048) * DM; ldk = DM; }
        else if (r < 2816) { r -= 2560; W = C.in[opq(I_WK)] + (size_t)l * DM * DQ; N = DQ; ks = C.in[opq(I_GMEM)] + l * DM; dst = WSP(bf16_t, WS_WKV) + ((size_t)l * 1024) * DM; ldk = DM; }
        else if (r < 3072) { r -= 2816; W = C.in[opq(I_WV)] + (size_t)l * DM * DQ; N = DQ; ks = C.in[opq(I_GMEM)] + l * DM; dst = WSP(bf16_t, WS_WKV) + ((size_t)l * 1024 + 512) * DM; ldk = DM; }
        else if (r < 3328) { r -= 3072; W = C.in[opq(I_WBP)] + (size_t)l * DPOOL * DM; N = DM; dst = WSP(bf16_t, WS_WBR) + (size_t)l * DM * DMIX; ldk = DMIX; }
        else if (r < 3840) { r -= 3328; W = C.in[opq(I_WBR)] + (size_t)l * DRNN * DM; N = DM; dst = WSP(bf16_t, WS_WBR) + (size_t)l * DM * DMIX + 512; ldk = DMIX; }
        else if (r < 4096) { r -= 3840; W = C.in[opq(I_WBA)] + (size_t)l * DQ * DM; N = DM; dst = WSP(bf16_t, WS_WBR) + (size_t)l * DM * DMIX + 1536; ldk = DMIX; }
        else if (r < 4608) { r -= 4096; W = C.in[opq(I_WOUT)] + (size_t)l * DM * DM; N = DM; dst = WSP(bf16_t, WS_WOUT) + (size_t)l * DM * DM; ldk = DM; }
        else if (r < 7680) { r -= 4608; W = C.in[opq(I_WUP)] + (size_t)l * DM * 2 * DFF; N = 2 * DFF; ks = C.in[opq(I_GFFN)] + l * DM; dst = WSP(bf16_t, WS_WUP) + (size_t)l * 2 * DFF * DM; ldk = DM; }
        else               { r -= 7680; W = C.in[opq(I_WDOWN)] + (size_t)l * DFF * DM; N = DM; dst = WSP(bf16_t, WS_WDOWN) + (size_t)l * DM * DFF; ldk = DFF; }
        tr_item(W, N, ks, dst, ldk, r, N / 32, scr, C.lane);
    }
    const int gt = C.bid * NTHR + C.tid, NT = C.G * NTHR;
    {
        GAS bf16_t* PBD = WSP(bf16_t, WS_PBD); const GAS float* pw = C.in[opq(I_POOLW)]; const GAS float* ps = C.in[opq(I_POOLS)];
        for (int i = gt; i < 2 * 2 * 256 * 256; i += NT) {
            const int k = i & 255, n = (i >> 8) & 255, pn = (i >> 16) & 1, l = i >> 17;
            const int gn = 2 * pn + (n >> 7), gk = 2 * pn + (k >> 7);
            float v = 0.f;
            if (gn == gk) v = pw[(((size_t)l * 4 + gn) * 128 + (k & 127)) * 128 + (n & 127)] * ps[l * DPOOL + gn * 128 + (n & 127)];
            PBD[i] = (bf16_t)(cvt_pk_bf16(v, 0.f) & 0xffffu);
        }
        GAS bf16_t* RW = WSP(bf16_t, WS_RW); const GAS float* wa = C.in[opq(I_RWA)]; const GAS float* wx = C.in[opq(I_RWX)];
        for (int i = gt; i < 2 * 8 * 256 * 128; i += NT) {
            const int k = i & 127, n = (i >> 7) & 255, lb = i >> 15;
            const float v = (n < 128) ? wa[((size_t)lb * 128 + k) * 128 + n] : wx[((size_t)lb * 128 + k) * 128 + (n - 128)];
            RW[i] = (bf16_t)(cvt_pk_bf16(v, 0.f) & 0xffffu);
        }
    }
    for (int m = gw; m < MT + MEMROWS; m += NGW) {
        if (m < MT) { const GAS float* xr = (m < MPR) ? C.in[opq(I_XP)] + (size_t)m * DM : C.in[opq(I_XS)] + (size_t)(m - MPR) * DM;
            row_to_bf16_ssq(xr, WSP(bf16_t, WS_HB) + (size_t)m * DM, WSP(float, WS_SSQ1) + (size_t)m * 16, C.lane); }
        else { const int r = m - MT; row_to_bf16_ssq(C.in[opq(I_MEM)] + (size_t)r * DM, WSP(bf16_t, WS_MEMB) + (size_t)r * DM, WSP(float, WS_SSQM) + (size_t)r * 16, C.lane); }
    }
}

constexpr float ATT_C = 0.08838834764831845f * 1.4426950408889634f;
__device__ __forceinline__ void attn16_full(const GAS bf16_t* qrow, const GAS bf16_t* Kb, int ldk, const GAS bf16_t* VT, GAS bf16_t* orow, int lane) {
    const int q = lane & 15, g = lane >> 4;
    bf16x8 qf[4];
#pragma unroll
    for (int ks = 0; ks < 4; ++ks) qf[ks] = *(const GAS bf16x8*)(qrow + 32 * ks + 8 * g);
    f32x4 s[16];
    const GAS bf16_t* kr = Kb + (size_t)q * ldk + 8 * g;
#pragma unroll
    for (int t = 0; t < 16; ++t) {
        asm volatile("" : "+v"(kr));
        f32x4 a = (f32x4){0.f, 0.f, 0.f, 0.f};
#pragma unroll
        for (int ks = 0; ks < 4; ++ks) a = __builtin_amdgcn_mfma_f32_16x16x32_bf16(*(const GAS bf16x8*)(kr + 32 * ks), qf[ks], a, 0, 0, 0);
        s[t] = a;
        kr += (size_t)16 * ldk;
    }
    float mx = -3.0e38f;
#pragma unroll
    for (int t = 0; t < 16; ++t) mx = fmaxf(fmaxf(fmaxf(mx, s[t][0]), fmaxf(s[t][1], s[t][2])), s[t][3]);
    mx = fmaxf(mx, __shfl_xor(mx, 16)); mx = fmaxf(mx, __shfl_xor(mx, 32));
    float sum = 0.f;
#pragma unroll
    for (int t = 0; t < 16; ++t)
#pragma unroll
        for (int r = 0; r < 4; ++r) { const float p = __builtin_amdgcn_exp2f((s[t][r] - mx) * ATT_C); s[t][r] = p; sum += p; }
    sum += __shfl_xor(sum, 16); sum += __shfl_xor(sum, 32);
    const float inv = 1.0f / sum;
    bf16x8 pf[8];
#pragma unroll
    for (int ks = 0; ks < 8; ++ks) { const u32x4 w = pack8(s[2 * ks], s[2 * ks + 1]); pf[ks] = __builtin_bit_cast(bf16x8, w); }
    const GAS bf16_t* vr = VT + (size_t)q * NMEM + 4 * g; GAS bf16_t* op = orow + 4 * g;
#pragma unroll
    for (int nt = 0; nt < 8; ++nt) {
        asm volatile("" : "+v"(vr), "+v"(op));
        f32x4 o = (f32x4){0.f, 0.f, 0.f, 0.f};
#pragma unroll
        for (int ks = 0; ks < 8; ++ks) {
            const u32x2 lo = *(const GAS u32x2*)(vr + 32 * ks), hi = *(const GAS u32x2*)(vr + 32 * ks + 16);
            const u32x4 w = (u32x4){lo.x, lo.y, hi.x, hi.y};
            o = __builtin_amdgcn_mfma_f32_16x16x32_bf16(__builtin_bit_cast(bf16x8, w), pf[ks], o, 0, 0, 0);
        }
        *(GAS u32x2*)op = pack4(o * inv);
        vr += 16 * NMEM; op += 16;
    }
}
__device__ __forceinline__ void phase_attention(const Ctx& C, int l) {
    GAS bf16_t* Z = WSP(bf16_t, WS_Z);
    for (int id = C.bid; id < 256; id += C.G) {
        const int x = id & 7, j = id >> 3, pair = x * 4 + (j & 3), qb = j >> 2, b = pair >> 2, h = pair & 3;
        const GAS bf16_t* Kb = WSP(bf16_t, WS_KVB) + ((size_t)l * MEMROWS + b * NMEM) * 512 + h * HDIM;
        const GAS bf16_t* VT = WSP(bf16_t, WS_VTB) + (((size_t)l * NBP + b) * NHEAD + h) * HDIM * NMEM;
#pragma unroll 1
        for (int kb = 0; kb < 2; ++kb) {
            const int row = b * TP + qb * 256 + C.wave * 32 + kb * 16 + (C.lane & 15);
            GAS bf16_t* qp = Z + (size_t)row * DMIX + (DPOOL + DRNN) + h * HDIM;
            attn16_full(qp, Kb, 512, VT, qp, C.lane);
        }
    }
    LAS float* ML = (LAS float*)(C.lds + RING_OFF);
    LAS float* OP = (LAS float*)(C.lds + RING_OFF + 1024);
    for (int id = C.bid; id < NBS * NHEAD; id += C.G) {
        const int b = id >> 2, h = id & 3, w = C.wave, q = C.lane & 15, g = C.lane >> 4;
        const GAS float* Kc = C.in[opq(I_CK)] + ((((size_t)l * NBS + b) * NMEM) * NHEAD + h) * HDIM;
        const GAS float* Vc = C.in[opq(I_CV)] + ((((size_t)l * NBS + b) * NMEM) * NHEAD + h) * HDIM;
        const GAS bf16_t* qrow = Z + (size_t)(MPR + b * TS + (q & 7)) * DMIX + (DPOOL + DRNN) + h * HDIM;
        bf16x8 qf[4];
#pragma unroll
        for (int ks = 0; ks < 4; ++ks) qf[ks] = *(const GAS bf16x8*)(qrow + 32 * ks + 8 * g);
        f32x4 s[2];
#pragma unroll
        for (int t = 0; t < 2; ++t) {
            f32x4 a = (f32x4){0.f, 0.f, 0.f, 0.f}; const GAS float* kr = Kc + (size_t)(32 * w + 16 * t + q) * (NHEAD * HDIM) + 8 * g;
#pragma unroll
            for (int ks = 0; ks < 4; ++ks) { const u32x4 kw = pack8(*(const GAS f32x4*)(kr + 32 * ks), *(const GAS f32x4*)(kr + 32 * ks + 4));
                a = __builtin_amdgcn_mfma_f32_16x16x32_bf16(__builtin_bit_cast(bf16x8, kw), qf[ks], a, 0, 0, 0); }
            s[t] = a;
        }
        float mx = fmaxf(fmaxf(fmaxf(s[0][0], s[0][1]), fmaxf(s[0][2], s[0][3])), fmaxf(fmaxf(s[1][0], s[1][1]), fmaxf(s[1][2], s[1][3])));
        mx = fmaxf(mx, __shfl_xor(mx, 16)); mx = fmaxf(mx, __shfl_xor(mx, 32));
        float sum = 0.f;
#pragma unroll
        for (int t = 0; t < 2; ++t)
#pragma unroll
            for (int r = 0; r < 4; ++r) { const float p = __builtin_amdgcn_exp2f((s[t][r] - mx) * ATT_C); s[t][r] = p; sum += p; }
        sum += __shfl_xor(sum, 16); sum += __shfl_xor(sum, 32);
        const u32x4 pw = pack8(s[0], s[1]); const bf16x8 pf = __builtin_bit_cast(bf16x8, pw);
        if (g == 0) { ML[(w * 16 + q) * 2 + 0] = mx; ML[(w * 16 + q) * 2 + 1] = sum; }
        const GAS float* vr = Vc + (size_t)(32 * w + 4 * g) * (NHEAD * HDIM) + q;
#pragma unroll
        for (int nt = 0; nt < 8; ++nt) {
            asm volatile("" : "+v"(vr));
            const GAS float* v0p = vr; const GAS float* v1p = vr + 2 * (NHEAD * HDIM); const GAS float* v2p = vr + 16 * (NHEAD * HDIM); const GAS float* v3p = vr + 18 * (NHEAD * HDIM);
            float v[8];
            v[0] = v0p[0]; v[1] = v0p[NHEAD * HDIM]; v[2] = v1p[0]; v[3] = v1p[NHEAD * HDIM];
            v[4] = v2p[0]; v[5] = v2p[NHEAD * HDIM]; v[6] = v3p[0]; v[7] = v3p[NHEAD * HDIM];
            vr += 16;
            u32x4 vw; vw.x = cvt_pk_bf16(v[0], v[1]); vw.y = cvt_pk_bf16(v[2], v[3]); vw.z = cvt_pk_bf16(v[4], v[5]); vw.w = cvt_pk_bf16(v[6], v[7]);
            const f32x4 o = __builtin_amdgcn_mfma_f32_16x16x32_bf16(__builtin_bit_cast(bf16x8, vw), pf, (f32x4){0.f, 0.f, 0.f, 0.f}, 0, 0, 0);
            if (q < 8) *(LAS f32x4*)(OP + (w * 8 + q) * 128 + 16 * nt + 4 * g) = o;
        }
        __syncthreads();
        {
            const int qo = C.tid >> 6, d2 = (C.tid & 63) * 2;
            float mw[8], M = -3.0e38f;
#pragma unroll
            for (int ww = 0; ww < 8; ++ww) { mw[ww] = ML[(ww * 16 + qo) * 2]; M = fmaxf(M, mw[ww]); }
            float L = 0.f, o0 = 0.f, o1 = 0.f;
#pragma unroll
            for (int ww = 0; ww < 8; ++ww) { const float f = __builtin_amdgcn_exp2f((mw[ww] - M) * ATT_C); L += f * ML[(ww * 16 + qo) * 2 + 1];
                const f32x2 ov = *(const LAS f32x2*)(OP + (ww * 8 + qo) * 128 + d2); o0 += f * ov[0]; o1 += f * ov[1]; }
            const float inv = 1.0f / L;
            *(GAS unsigned*)(Z + (size_t)(MPR + b * TS + qo) * DMIX + (DPOOL + DRNN) + h * HDIM + d2) = cvt_pk_bf16(o0 * inv, o1 * inv);
        }
        __syncthreads();
    }
}

__device__ __forceinline__ void ld8(const GAS bf16_t* p, float (&v)[8]) { const u32x4 w = *(const GAS u32x4*)p; v[0] = bf_lo(w.x); v[1] = bf_hi(w.x); v[2] = bf_lo(w.y); v[3] = bf_hi(w.y); v[4] = bf_lo(w.z); v[5] = bf_hi(w.z); v[6] = bf_lo(w.w); v[7] = bf_hi(w.w); }
__device__ __forceinline__ void ld8f(const GAS float* p, float (&v)[8]) { const f32x4 a = *(const GAS f32x4*)p, b = *(const GAS f32x4*)(p + 4); v[0] = a[0]; v[1] = a[1]; v[2] = a[2]; v[3] = a[3]; v[4] = b[0]; v[5] = b[1]; v[6] = b[2]; v[7] = b[3]; }
__device__ __forceinline__ void st8(GAS bf16_t* p, const float (&v)[8]) { u32x4 w; w.x = cvt_pk_bf16(v[0], v[1]); w.y = cvt_pk_bf16(v[2], v[3]); w.z = cvt_pk_bf16(v[4], v[5]); w.w = cvt_pk_bf16(v[6], v[7]); *(GAS u32x4*)p = w; }
__device__ __forceinline__ void st8f(GAS float* p, const float (&v)[8]) { *(GAS f32x4*)p = (f32x4){v[0], v[1], v[2], v[3]}; *(GAS f32x4*)(p + 4) = (f32x4){v[4], v[5], v[6], v[7]}; }

__device__ __forceinline__ void phase_mix_elem(const Ctx& C, int l) {
    const GAS bf16_t* Z = WSP(bf16_t, WS_Z); GAS bf16_t* DBf = WSP(bf16_t, WS_DB); GAS bf16_t* XC = WSP(bf16_t, WS_XC);
    const GAS float* spool = C.in[opq(I_SPOOL)] + (size_t)l * NBS * 15 * DPOOL; const GAS float* srconv = C.in[opq(I_SRC)] + (size_t)l * NBS * 3 * DRNN;
    const GAS float* cw = C.in[opq(I_RCW)] + (size_t)l * 4 * DRNN; const GAS float* cb = C.in[opq(I_RCB)] + (size_t)l * DRNN;
    GAS float* out = C.out;
    const long total = (long)MT * 192;
    for (long idx = (long)C.bid * NTHR + C.tid; idx < total; idx += (long)C.G * NTHR) {
        const int m = (int)(idx / 192), c8 = (int)(idx % 192);
        const bool pr = m < MPR; const int b = pr ? (m >> 11) : ((m - MPR) >> 3), t = pr ? (m & 2047) : ((m - MPR) & 7);
        if (c8 < 64) {
            const int ch = c8 * 8, g = ch >> 7, w = 2 << g;
            float u[8], sum[8]; ld8(Z + (size_t)m * DMIX + ch, u);
#pragma unroll
            for (int i = 0; i < 8; ++i) sum[i] = u[i];
            for (int j = 1; j < w; ++j) { const int tt = t - j; float v[8];
                if (tt >= 0) { ld8(Z + (size_t)(m - j) * DMIX + ch, v); } else if (!pr) { ld8f(spool + ((size_t)b * 15 + (15 + tt)) * DPOOL + ch, v); } else break;
#pragma unroll
                for (int i = 0; i < 8; ++i) sum[i] += v[i]; }
            const float cnt = pr ? (float)((t + 1 < w) ? t + 1 : w) : (float)w; const float ic = 1.0f / cnt;
            float d[8];
#pragma unroll
            for (int i = 0; i < 8; ++i) d[i] = sum[i] * ic - u[i];
            st8(DBf + (size_t)m * DPOOL + ch, d);
            if (pr) { if (t >= TP - 15) st8f(out + O_PPOOL + (((size_t)l * NBP + b) * 15 + (t - (TP - 15))) * DPOOL + ch, u); }
            else { st8f(out + O_SPOOL + (((size_t)l * NBS + b) * 15 + 7 + t) * DPOOL + ch, u);
                if (t == 0) for (int j = 0; j < 7; ++j) { float v[8]; ld8f(spool + ((size_t)b * 15 + j + 8) * DPOOL + ch, v); st8f(out + O_SPOOL + (((size_t)l * NBS + b) * 15 + j) * DPOOL + ch, v); } }
        } else {
            const int ch = (c8 - 64) * 8;
            float x[8], u[8]; ld8f(cb + ch, x);
#pragma unroll
            for (int j = 0; j < 4; ++j) { const int tt = t + j - 3; float v[8], wj[8]; bool have = true;
                if (tt >= 0) ld8(Z + (size_t)(m + j - 3) * DMIX + DPOOL + ch, v); else if (!pr) ld8f(srconv + ((size_t)b * 3 + (3 + tt)) * DRNN + ch, v); else have = false;
                if (have) { ld8f(cw + (size_t)j * DRNN + ch, wj);
#pragma unroll
                    for (int i = 0; i < 8; ++i) x[i] += wj[i] * v[i]; }
                if (j == 3) {
#pragma unroll
                    for (int i = 0; i < 8; ++i) u[i] = v[i]; } }
            st8(XC + (size_t)m * DRNN + ch, x);
            if (pr) { if (t >= TP - 3) st8f(out + O_PRC + (((size_t)l * NBP + b) * 3 + (t - (TP - 3))) * DRNN + ch, u); }
            else { if (t >= TS - 3) st8f(out + O_SRC + (((size_t)l * NBS + b) * 3 + (t - (TS - 3))) * DRNN + ch, u); }
        }
    }
}

__device__ __forceinline__ void scan_coef(const GAS float* lam, int ch, float (&nl)[4]) {
#pragma unroll
    for (int i = 0; i < 4; ++i) { const float x = -lam[ch + i]; const float sp = fmaxf(x, 0.f) + log1pf(__expf(-fabsf(x))); nl[i] = -8.0f * sp; }
}
__device__ __forceinline__ void scan_step(const GAS bf16_t* Zr, const GAS bf16_t* Pr, const float (&nl)[4], float (&h)[4], float (*A)[4]) {
    const f32x4 r = unpack4(*(const GAS u32x2*)Zr), p = unpack4(*(const GAS u32x2*)Pr);
#pragma unroll
    for (int i = 0; i < 4; ++i) { const float la = r[i] * nl[i]; const float a = __expf(la); const float beta = sqrtf(-expm1f(2.0f * la));
        h[i] = a * h[i] + beta * p[i]; if (A) (*A)[i] *= a; }
}
__device__ __forceinline__ void phase_scan_a(const Ctx& C, int l) {
    GAS bf16_t* Z = WSP(bf16_t, WS_Z); const GAS bf16_t* PP = WSP(bf16_t, WS_PP); GAS float* AGG = WSP(float, WS_AGG);
    const GAS float* lam = C.in[opq(I_LAM)] + (size_t)l * DRNN;
    for (int gt = C.bid * NTHR + C.tid; gt < NBP * 64 * 256; gt += C.G * NTHR) {
        const int unit = gt >> 8, ch = (gt & 255) * 4, b = unit >> 6, c = unit & 63;
        float nl[4]; scan_coef(lam, ch, nl);
        float h[4] = {0.f, 0.f, 0.f, 0.f}, A[4] = {1.f, 1.f, 1.f, 1.f};
        const size_t row0 = (size_t)b * TP + c * 32;
#pragma unroll 4
        for (int t = 0; t < 32; ++t) scan_step(Z + (row0 + t) * DMIX + DPOOL + ch, PP + (row0 + t) * DRNN + ch, nl, h, &A);
        *(GAS f32x4*)(AGG + ((size_t)(b * 64 + c)) * DRNN + ch) = (f32x4){A[0], A[1], A[2], A[3]};
        *(GAS f32x4*)(AGG + (size_t)NBP * 64 * DRNN + ((size_t)(b * 64 + c)) * DRNN + ch) = (f32x4){h[0], h[1], h[2], h[3]};
    }
    for (int gt = C.bid * NTHR + C.tid; gt < NBS * 256; gt += C.G * NTHR) {
        const int b = gt >> 8, ch = (gt & 255) * 4;
        float nl[4]; scan_coef(lam, ch, nl);
        const f32x4 h0 = *(const GAS f32x4*)(C.in[opq(I_SRH)] + ((size_t)l * NBS + b) * DRNN + ch);
        float h[4] = {h0[0], h0[1], h0[2], h0[3]};
        const size_t row0 = (size_t)MPR + b * TS;
#pragma unroll
        for (int t = 0; t < TS; ++t) { scan_step(Z + (row0 + t) * DMIX + DPOOL + ch, PP + (row0 + t) * DRNN + ch, nl, h, nullptr);
            *(GAS u32x2*)(Z + (row0 + t) * DMIX + DPOOL + ch) = pack4((f32x4){h[0], h[1], h[2], h[3]}); }
        *(GAS f32x4*)(C.out + O_SRH + ((size_t)l * NBS + b) * DRNN + ch) = (f32x4){h[0], h[1], h[2], h[3]};
    }
}
__device__ __forceinline__ void phase_scan_b(const Ctx& C, int l) {
    GAS bf16_t* Z = WSP(bf16_t, WS_Z); const GAS bf16_t* PP = WSP(bf16_t, WS_PP); const GAS float* AGG = WSP(float, WS_AGG);
    const GAS float* lam = C.in[opq(I_LAM)] + (size_t)l * DRNN;
    for (int gt = C.bid * NTHR + C.tid; gt < NBP * 64 * 256; gt += C.G * NTHR) {
        const int unit = gt >> 8, ch = (gt & 255) * 4, b = unit >> 6, c = unit & 63;
        float nl[4]; scan_coef(lam, ch, nl);
        float h[4] = {0.f, 0.f, 0.f, 0.f};
        for (int cc = 0; cc < c; ++cc) {
            const f32x4 a = *(const GAS f32x4*)(AGG + ((size_t)(b * 64 + cc)) * DRNN + ch), bb = *(const GAS f32x4*)(AGG + (size_t)NBP * 64 * DRNN + ((size_t)(b * 64 + cc)) * DRNN + ch);
#pragma unroll
            for (int i = 0; i < 4; ++i) h[i] = a[i] * h[i] + bb[i];
        }
        const size_t row0 = (size_t)b * TP + c * 32;
#pragma unroll 4
        for (int t = 0; t < 32; ++t) { scan_step(Z + (row0 + t) * DMIX + DPOOL + ch, PP + (row0 + t) * DRNN + ch, nl, h, nullptr);
            *(GAS u32x2*)(Z + (row0 + t) * DMIX + DPOOL + ch) = pack4((f32x4){h[0], h[1], h[2], h[3]}); }
        if (c == 63) *(GAS f32x4*)(C.out + O_PRH + ((size_t)l * NBP + b) * DRNN + ch) = (f32x4){h[0], h[1], h[2], h[3]};
    }
}

__device__ __forceinline__ float gelu_tanh(float x) { const float y = 0.7978845608028654f * (x + 0.044715f * x * x * x); return x * sigmoidf_(2.0f * y); }
__device__ __forceinline__ void phase_ffn_elem(const Ctx& C, int l) {
    const GAS bf16_t* GV = WSP(bf16_t, WS_GV); GAS bf16_t* ACT = WSP(bf16_t, WS_ACT);
    const GAS float* sfc = C.in[opq(I_SFC)] + (size_t)l * NBS * 2 * DFF; const GAS float* cw = C.in[opq(I_FCW)] + (size_t)l * 3 * DFF; const GAS float* cb = C.in[opq(I_FCB)] + (size_t)l * DFF;
    GAS float* out = C.out;
    const long total = (long)MT * 384;
    for (long idx = (long)C.bid * NTHR + C.tid; idx < total; idx += (long)C.G * NTHR) {
        const int m = (int)(idx / 384), ch = (int)(idx % 384) * 8;
        const bool pr = m < MPR; const int b = pr ? (m >> 11) : ((m - MPR) >> 3), t = pr ? (m & 2047) : ((m - MPR) & 7);
        float x[8], gp[8], val[8]; ld8f(cb + ch, x);
#pragma unroll
        for (int j = 0; j < 3; ++j) { const int tt = t + j - 2; float v[8], wj[8]; bool have = true;
            if (tt >= 0) ld8(GV + (size_t)(m + j - 2) * (2 * DFF) + ch, v); else if (!pr) ld8f(sfc + ((size_t)b * 2 + (2 + tt)) * DFF + ch, v); else have = false;
            if (have) { ld8f(cw + (size_t)j * DFF + ch, wj);
#pragma unroll
                for (int i = 0; i < 8; ++i) x[i] += wj[i] * v[i]; }
            if (j == 2) {
#pragma unroll
                for (int i = 0; i < 8; ++i) gp[i] = v[i]; } }
        ld8(GV + (size_t)m * (2 * DFF) + DFF + ch, val);
        float a[8];
#pragma unroll
        for (int i = 0; i < 8; ++i) a[i] = gelu_tanh(x[i]) * val[i];
        st8(ACT + (size_t)m * DFF + ch, a);
        if (pr) { if (t >= TP - 2) st8f(out + O_PFC + (((size_t)l * NBP + b) * 2 + (t - (TP - 2))) * DFF + ch, gp); }
        else { if (t >= TS - 2) st8f(out + O_SFC + (((size_t)l * NBS + b) * 2 + (t - (TS - 2))) * DFF + ch, gp); }
    }
}

__device__ __forceinline__ void phase_final(const Ctx& C) {
    const GAS float* H = WSP(float, WS_H); const GAS float* ssq = WSP(float, WS_SSQ1); const GAS float* gf = C.in[opq(I_GFIN)];
    const int gw = C.bid * NWAVES + C.wave, NGW = C.G * NWAVES;
    for (int m = gw; m < MT; m += NGW) {
        const GAS f32x4* sp = (const GAS f32x4*)(ssq + (size_t)m * 16);
        const f32x4 p0 = sp[0], p1 = sp[1], p2 = sp[2], p3 = sp[3];
        const float s = ((p0[0] + p0[1]) + (p0[2] + p0[3])) + ((p1[0] + p1[1]) + (p1[2] + p1[3])) + ((p2[0] + p2[1]) + (p2[2] + p2[3])) + ((p3[0] + p3[1]) + (p3[2] + p3[3]));
        const float rs = rsqrtf(s * (1.0f / 1024.0f) + EPSN);
        const GAS f32x4* hr = (const GAS f32x4*)(H + (size_t)m * DM) + C.lane; const GAS f32x4* gr = (const GAS f32x4*)gf + C.lane; GAS f32x4* orow = (GAS f32x4*)(C.out + O_Y + (size_t)m * DM) + C.lane;
#pragma unroll
        for (int j = 0; j < 4; ++j) orow[64 * j] = hr[64 * j] * rs * gr[64 * j];
    }
}

#define LDSR (C.lds + RING_OFF)
__device__ __forceinline__ int rot(const Ctx& C, int start) { return (C.bid + C.G - (start % C.G)) % C.G; }

__device__ __forceinline__ void phase_p1(const Ctx& C, int l) {
    { pg8::Gemm g{WSP(bf16_t, WS_HB), WSP(bf16_t, WS_W1) + (size_t)l * 5120 * DM, DM, DM, DM / 64, 0};
      pg8::StaticOrder S; S.init(MT / 256, 20, C.G, C.bid);
      EpiP1 E{WSP(float, WS_SSQ1), WSP(bf16_t, WS_Z), WSP(bf16_t, WS_G), C.in[opq(I_BGATE)] + (size_t)l * 3 * DM};
      pg8::gemm_phase<EpiP1, pg8::StaticOrder, true>(LDSR, C.wave, g, S, E); }
    if (l == 0) {
      pg8::Gemm g{WSP(bf16_t, WS_MEMB), WSP(bf16_t, WS_WKV), DM, DM, DM / 64, 0};
      pg8::StaticOrder S; S.init(MEMROWS / 256, 8, C.G, rot(C, (MT / 256) * 20));
      EpiKV E{WSP(float, WS_SSQM), C.out, WSP(bf16_t, WS_KVB), WSP(bf16_t, WS_VTB)};
      pg8::gemm_phase<EpiKV, pg8::StaticOrder, true>(LDSR, C.wave, g, S, E); }
}
__device__ __forceinline__ void phase_p2b(const Ctx& C, int l) {
    { pg8::Gemm g{WSP(bf16_t, WS_XC), WSP(bf16_t, WS_RW) + (size_t)l * 8 * 256 * 128, DRNN, 128, 2, 128};
      pg8::StaticOrder S; S.init(MT / 256, 8, C.G, C.bid);
      EpiRnn E{C.in[opq(I_RBA)] + (size_t)l * DRNN, C.in[opq(I_RBX)] + (size_t)l * DRNN, WSP(bf16_t, WS_XC), WSP(bf16_t, WS_Z), WSP(bf16_t, WS_PP)};
      pg8::gemm_phase<EpiRnn, pg8::StaticOrder, true>(LDSR, C.wave, g, S, E); }
    { pg8::Gemm g{WSP(bf16_t, WS_DB), WSP(bf16_t, WS_PBD) + (size_t)l * 2 * 256 * 256, DPOOL, 256, 4, 256};
      pg8::StaticOrder S; S.init(MT / 256, 2, C.G, rot(C, (MT / 256) * 8));
      EpiPool E{WSP(bf16_t, WS_Z)};
      pg8::gemm_phase<EpiPool, pg8::StaticOrder, true>(LDSR, C.wave, g, S, E); }
}
__device__ __forceinline__ void phase_p3(const Ctx& C, int l) {
    const GAS bf16_t* Y = WSP(bf16_t, WS_Z); const GAS bf16_t* WB = WSP(bf16_t, WS_WBR) + (size_t)l * DM * DMIX;
    pg8::StaticOrder S; S.init(MT / 256, 4, C.G, C.bid);
    { pg8::Gemm g{Y, WB, DMIX, DMIX, DPOOL / 64, 0};
      EpiMrg<0> E{WSP(bf16_t, WS_G), WSP(float, WS_MRG), WSP(bf16_t, WS_MB)}; pg8::gemm_phase<EpiMrg<0>, pg8::StaticOrder, true>(LDSR, C.wave, g, S, E); }
    { pg8::Gemm g{Y + DPOOL, WB + DPOOL, DMIX, DMIX, DRNN / 64, 0};
      EpiMrg<1> E{WSP(bf16_t, WS_G), WSP(float, WS_MRG), WSP(bf16_t, WS_MB)}; pg8::gemm_phase<EpiMrg<1>, pg8::StaticOrder, true>(LDSR, C.wave, g, S, E); }
    { pg8::Gemm g{Y + DPOOL + DRNN, WB + DPOOL + DRNN, DMIX, DMIX, DQ / 64, 0};
      EpiMrg<2> E{WSP(bf16_t, WS_G), WSP(float, WS_MRG), WSP(bf16_t, WS_MB)}; pg8::gemm_phase<EpiMrg<2>, pg8::StaticOrder, true>(LDSR, C.wave, g, S, E); }
}
__device__ __forceinline__ void phase_p4(const Ctx& C, int l) {
    pg8::Gemm g{WSP(bf16_t, WS_MB), WSP(bf16_t, WS_WOUT) + (size_t)l * DM * DM, DM, DM, DM / 64, 0};
    pg8::StaticOrder S; S.init(MT / 256, 4, C.G, C.bid);
    const GAS float* bP = (l == 0) ? C.in[opq(I_XP)] : WSP(float, WS_H); const GAS float* bS = (l == 0) ? C.in[opq(I_XS)] : WSP(float, WS_H) + (size_t)MPR * DM;
    EpiRes E{bP, bS, WSP(float, WS_H), WSP(bf16_t, WS_HB), WSP(float, WS_SSQ2)};
    pg8::gemm_phase<EpiRes, pg8::StaticOrder, true>(LDSR, C.wave, g, S, E);
}
__device__ __forceinline__ void phase_p5(const Ctx& C, int l) {
    pg8::Gemm g{WSP(bf16_t, WS_HB), WSP(bf16_t, WS_WUP) + (size_t)l * 2 * DFF * DM, DM, DM, DM / 64, 0};
    pg8::StaticOrder S; S.init(MT / 256, 24, C.G, C.bid);
    EpiUp E{WSP(float, WS_SSQ2), WSP(bf16_t, WS_GV)};
    pg8::gemm_phase<EpiUp, pg8::StaticOrder, true>(LDSR, C.wave, g, S, E);
}
__device__ __forceinline__ void phase_p7(const Ctx& C, int l) {
    pg8::Gemm g{WSP(bf16_t, WS_ACT), WSP(bf16_t, WS_WDOWN) + (size_t)l * DM * DFF, DFF, DFF, DFF / 64, 0};
    pg8::StaticOrder S; S.init(MT / 256, 4, C.G, C.bid);
    EpiRes E{WSP(float, WS_H), WSP(float, WS_H) + (size_t)MPR * DM, WSP(float, WS_H), WSP(bf16_t, WS_HB), WSP(float, WS_SSQ1)};
    pg8::gemm_phase<EpiRes, pg8::StaticOrder, true>(LDSR, C.wave, g, S, E);
}

constexpr int NPHASE = 22;
#ifndef MK_ONE_LAUNCH
#define MK_ONE_LAUNCH 1
#endif

__global__ void __launch_bounds__(NTHR, 2) fwd_kernel(Args args) {
    extern __shared__ __attribute__((aligned(16))) unsigned char lds_raw[];
    Ctx C;
    const int wave0 = __builtin_amdgcn_readfirstlane((int)threadIdx.x >> 6);
    C.lds = (LAS unsigned char*)lds_raw; C.tid = threadIdx.x; C.lane = C.tid & 63; C.wave = wave0;
    C.G = gridDim.x; C.bid = blockIdx.x; C.in = nullptr; C.out = args.out; C.ws = args.ws;
    volatile LAS unsigned* MISC = (volatile LAS unsigned*)(C.lds + MISC_OFF);
    for (int u = C.tid; u < (LDS_BYTES - LDSCTL_OFF) / 4; u += NTHR) ((LAS unsigned*)(C.lds + LDSCTL_OFF))[u] = 0u;
    __syncthreads();
    const int lo = args.ph_lo, hi = args.ph_hi;
    XcdBarrier bar; bar.bar = (unsigned*)(C.ws + WS_CTL) + CW_BAR; bar.x = 0; bar.st = nullptr;
    if (hi - lo > 1) bar = xcd_barrier_post((unsigned*)(C.ws + WS_CTL) + CW_BAR, MISC + 8);
#define PH_SETUP() do { int wave_ = wave0; asm volatile("" : "+s"(wave_)); const int lane_ = pg8::fresh_lane(); \
        C.in = (const GAS float* const CAS*)args.in; C.tid = wave_ * 64 + lane_; C.lane = lane_; C.wave = wave_; C.bid = blockIdx.x; C.ws = args.ws; C.out = args.out; } while (0)
#define PH_BAR(k) do { if ((k) + 1 < hi) { int w_ = wave0; asm volatile("" : "+s"(w_)); xcd_barrier(bar, w_ == 0 && pg8::fresh_lane() == 0); } } while (0)
#define PH(k, body) do { if (lo <= (k) && (k) < hi) { PH_SETUP(); body; PH_BAR(k); } } while (0)
#ifndef PHM
#define PHM 0xFFFF
#endif
    PH(0, if (PHM & 1) phase_prologue(C));
#define LAYER(l) do { const int pb = 1 + 10 * (l); \
        PH(pb + 0, if (PHM & 4) phase_p1(C, l)); \
        PH(pb + 1, if (PHM & 8) phase_attention(C, l); if (PHM & 16) phase_mix_elem(C, l)); \
        PH(pb + 2, if (PHM & 32) phase_p2b(C, l)); \
        PH(pb + 3, if (PHM & 64) phase_scan_a(C, l)); \
        PH(pb + 4, if (PHM & 128) phase_scan_b(C, l)); \
        PH(pb + 5, if (PHM & 256) phase_p3(C, l)); \
        PH(pb + 6, if (PHM & 512) phase_p4(C, l)); \
        PH(pb + 7, if (PHM & 1024) phase_p5(C, l)); \
        PH(pb + 8, if (PHM & 2048) phase_ffn_elem(C, l)); \
        PH(pb + 9, if (PHM & 4096) phase_p7(C, l)); } while (0)
    LAYER(0);
    LAYER(1);
    PH(NPHASE - 1, if (PHM & 2) phase_final(C));
}

extern "C" void kernel_launch(void* const* d_in, const int* in_sizes, int n_in, void* d_out, int out_size, void* d_ws, size_t ws_size, hipStream_t stream) {
    static int grid = 0;
    if (grid == 0) {
        if (n_in != N_IN || out_size != (int)O_END || ws_size < WS_END) {
            fprintf(stderr, "kernel_launch: built for %d inputs, %zu outputs, >= %zu bytes of workspace; got n_in %d, out %d, ws %zu; nothing launched\n", (int)N_IN, (size_t)O_END, (size_t)WS_END, n_in, out_size, ws_size); grid = -1; return; }
        int dev = 0, cus = 0, per_cu = 0;
        if (hipGetDevice(&dev) != hipSuccess || hipDeviceGetAttribute(&cus, hipDeviceAttributeMultiprocessorCount, dev) != hipSuccess) { fprintf(stderr, "kernel_launch: device query failed\n"); grid = -1; return; }
        if (hipFuncSetAttribute((const void*)fwd_kernel, hipFuncAttributeMaxDynamicSharedMemorySize, LDS_BYTES) != hipSuccess) { fprintf(stderr, "kernel_launch: hipFuncSetAttribute failed\n"); grid = -1; return; }
        if (hipOccupancyMaxActiveBlocksPerMultiprocessor(&per_cu, (const void*)fwd_kernel, NTHR, LDS_BYTES) != hipSuccess || per_cu < 1) { fprintf(stderr, "kernel_launch: occupancy query says %d blocks per CU\n", per_cu); per_cu = 1; }
        (void)hipGetLastError();
        grid = cus;
        if (grid > 256) grid = 256;
    }
    if (grid < 0) return;
    (void)hipMemsetAsync((char*)d_ws + WS_CTL, 0, CTL_ZERO_BYTES, stream);
    Args a{};
    for (int i = 0; i < N_IN; ++i) a.in[i] = (const GAS float*)d_in[i];
    a.out = (GAS float*)d_out; a.ws = (GAS unsigned char*)d_ws;
#if MK_ONE_LAUNCH
    a.ph_lo = 0; a.ph_hi = NPHASE;
    void* kargs[] = {&a};
    hipError_t e = hipLaunchCooperativeKernel((const void*)fwd_kernel, dim3(grid), dim3(NTHR), kargs, LDS_BYTES, stream);
    if (e != hipSuccess) fprintf(stderr, "kernel_launch: cooperative launch failed: %s (grid %d)\n", hipGetErrorString(e), grid);
#else
    for (int ph = 0; ph < NPHASE; ++ph) { a.ph_lo = ph; a.ph_hi = ph + 1; hipLaunchKernelGGL(fwd_kernel, dim3(grid), dim3(NTHR), LDS_BYTES, stream, a); }
#endif
}
```

```cpp
#include <hip/hip_runtime.h>
#include <cstdio>
#include <cstdint>

#define GAS __attribute__((address_space(1)))
#define LAS __attribute__((address_space(3)))
#define CAS __attribute__((address_space(4)))
typedef unsigned short bf16_t;
typedef short bf16x8 __attribute__((ext_vector_type(8)));
typedef float f32x4 __attribute__((ext_vector_type(4)));
typedef float f32x2 __attribute__((ext_vector_type(2)));
typedef unsigned u32x4 __attribute__((ext_vector_type(4)));
typedef unsigned u32x2 __attribute__((ext_vector_type(2)));
#define RLX_AGENT __ATOMIC_RELAXED, __HIP_MEMORY_SCOPE_AGENT
#define LDS_WAIT() asm volatile("s_waitcnt lgkmcnt(0)" ::: "memory")
#define VM_WAIT() asm volatile("s_waitcnt vmcnt(0)" ::: "memory")

namespace pg8 {
constexpr int BM = 256, BK = 64, HALF = 128, HTB = HALF * BK * 2  , STAGE_BYTES = 8 * HTB, NXCD = 8, WGM = 8;

__host__ __device__ __forceinline__ int lds_byte(int r, int c) { const int st = (r >> 4) * 2 + (c >> 5), rr = r & 15, cc = c & 31, ob = rr * 64 + cc * 2; return st * 1024 + (ob ^ (((ob >> 9) & 1) << 5)); }
__host__ __device__ __forceinline__ void stage_rc(int b, int& R, int& C) { const int st = b / 1024, sb = b % 1024, swz = sb ^ (((sb >> 9) & 1) << 5); R = (st >> 1) * 16 + swz / 64; C = (st & 1) * 32 + (swz % 64) / 2; }
__host__ __device__ __forceinline__ int perm32(int rho) { const int n = rho >> 4, i = rho & 15; return 8 * (i >> 2) + 4 * n + (i & 3); }

struct Unit { int pm, pn; };
struct Gemm { const GAS bf16_t* A; const GAS bf16_t* Bt; int lda, ldb, nt, a_pn; };

struct StaticOrder {
    int nM, nN, nwg, G, c;
    __host__ __device__ void init(int nM_, int nN_, int G_, int c_) { nM = nM_; nN = nN_; nwg = nM * nN; G = G_; c = c_; }
    __host__ __device__ bool next(int i, Unit& u) const {
        const long L = (long)i * G + c; if (L >= nwg) return false;
        int wgid = (int)L; { const int q = nwg / NXCD, r = nwg % NXCD, xcd = wgid % NXCD, off = wgid / NXCD; wgid = (xcd < r ? xcd * (q + 1) : r * (q + 1) + (xcd - r) * q) + off; }
        const int nig = WGM * nN, gid = wgid / nig, fm = gid * WGM, gsz = (nM - fm) < WGM ? (nM - fm) : WGM;
        u.pm = fm + ((wgid % nig) % gsz); u.pn = (wgid % nig) / gsz; return true;
    }
};

__device__ __forceinline__ int fresh_lane() { int l; asm volatile("v_mbcnt_lo_u32_b32 %0, -1, 0\n\tv_mbcnt_hi_u32_b32 %0, -1, %0" : "=v"(l)); return l; }
__device__ __forceinline__ unsigned cvt_pk_bf16(float lo, float hi) { unsigned r; asm volatile("v_cvt_pk_bf16_f32 %0, %1, %2" : "=v"(r) : "v"(lo), "v"(hi)); return r; }

template <class Epi, class Sched, bool ALIGN_EPI = false>
__device__ __forceinline__ void gemm_phase(LAS unsigned char* lds, const int wid, const Gemm g, const Sched& S, const Epi& E) {
    const int lane = fresh_lane(), tid = wid * 64 + lane, wr = wid >> 2, wc = wid & 3, fr = lane & 15, fq = lane >> 4;
    const int nt = g.nt;
    unsigned voffA[2], voffB[2];
#pragma unroll
    for (int i = 0; i < 2; ++i) { int R, C; stage_rc(tid * 16 + i * 8192, R, C); const int Rb = Epi::PERM ? ((R & ~31) + perm32(R & 31)) : R;
        voffA[i] = (unsigned)(R * g.lda + C) * 2u; voffB[i] = (unsigned)(Rb * g.ldb + C) * 2u; }
    const size_t kstep = (size_t)(BK * 2);
    const size_t hstepA = (size_t)HALF * g.lda * 2, hstepB = (size_t)HALF * g.ldb * 2;
    const size_t tstepA = 2 * hstepA, tstepB = 2 * hstepB;
    const size_t apn = (size_t)g.a_pn * 2;
    const unsigned ldsw = (unsigned)wid * 1024u;
    const int aoff = lds_byte(wr * 64 + fr, fq * 8), boff = lds_byte(wc * 32 + fr, fq * 8);
#define PG8_SA(b, h) (((b) * 2 + (h)) * HTB)
#define PG8_SB(b, h) ((4 + (b) * 2 + (h)) * HTB)
#define PG8_STAGE(bufoff, gbase, voff) do { const GAS char* gb_ = (gbase); asm volatile("" : "+s"(gb_));   \
        _Pragma("unroll") for (int _i = 0; _i < 2; ++_i) \
        __builtin_amdgcn_global_load_lds((const GAS unsigned*)(gb_ + (voff)[_i]), (LAS unsigned*)(lds + (bufoff) + ldsw + _i * 8192), 16, 0, 0); } while (0)
#define PG8_LDA(dst, b, h) do { _Pragma("unroll") for (int m = 0; m < 4; ++m) _Pragma("unroll") for (int k = 0; k < 2; ++k) dst[m][k] = *(const LAS bf16x8*)(lds + PG8_SA(b, h) + aoff + m * 2048 + k * 1024); } while (0)
#define PG8_LDB(dst, b, h) do { _Pragma("unroll") for (int n = 0; n < 2; ++n) _Pragma("unroll") for (int k = 0; k < 2; ++k) dst[n][k] = *(const LAS bf16x8*)(lds + PG8_SB(b, h) + boff + n * 2048 + k * 1024); } while (0)
#define PG8_MMA(ai, bj, At, Bt) do { __builtin_amdgcn_s_setprio(1); _Pragma("unroll") for (int m = 0; m < 4; ++m) _Pragma("unroll") for (int n = 0; n < 2; ++n) _Pragma("unroll") for (int k = 0; k < 2; ++k) \
        acc[ai][bj][m][n] = __builtin_amdgcn_mfma_f32_16x16x32_bf16(Bt[n][k], At[m][k], acc[ai][bj][m][n], 0, 0, 0); __builtin_amdgcn_s_setprio(0); } while (0)
#define PG8_WAIT_V(n) asm volatile("s_waitcnt vmcnt(" #n ")" ::: "memory")
#define PG8_WAIT_L(n) asm volatile("s_waitcnt lgkmcnt(" #n ")" ::: "memory")
#define PG8_BAR __builtin_amdgcn_s_barrier()
#define PG8_SCHED __builtin_amdgcn_sched_barrier(0)
    Unit cur, nxt; int ui = 0;
    if (!S.next(0, cur)) return;
    f32x4 acc[2][2][4][2];
#pragma unroll
    for (int a = 0; a < 2; ++a)
#pragma unroll
        for (int b = 0; b < 2; ++b)
#pragma unroll
            for (int m = 0; m < 4; ++m)
#pragma unroll
                for (int n = 0; n < 2; ++n) acc[a][b][m][n] = (f32x4){0.f, 0.f, 0.f, 0.f};
    bf16x8 At[4][2], B0[2][2], B1[2][2];
    const GAS char* cA = (const GAS char*)g.A + (size_t)cur.pm * tstepA + (size_t)cur.pn * apn; const GAS char* cB = (const GAS char*)g.Bt + (size_t)cur.pn * tstepB;
    PG8_STAGE(PG8_SB(0, 0), cB, voffB); PG8_STAGE(PG8_SB(0, 1), cB + hstepB, voffB); PG8_STAGE(PG8_SA(0, 0), cA, voffA); PG8_STAGE(PG8_SA(0, 1), cA + hstepA, voffA);
    if (wr == 1) PG8_BAR;
    PG8_WAIT_V(2); PG8_BAR;
    PG8_STAGE(PG8_SB(1, 0), cB + kstep, voffB); PG8_STAGE(PG8_SA(1, 0), cA + kstep, voffA); PG8_STAGE(PG8_SB(1, 1), cB + hstepB + kstep, voffB);
    PG8_WAIT_V(6); PG8_BAR;
    for (;;) {
        const bool has_next = S.next(ui + 1, nxt);
        const GAS char* nA = has_next ? (const GAS char*)g.A + (size_t)nxt.pm * tstepA + (size_t)nxt.pn * apn : cA; const GAS char* nB = has_next ? (const GAS char*)g.Bt + (size_t)nxt.pn * tstepB : cB;
        for (int t = 0; t < nt; t += 2) {
            const bool last = (t == nt - 2);
            const GAS char* a1 = cA + (size_t)(t + 1) * kstep;
            const GAS char* a2 = last ? nA : cA + (size_t)(t + 2) * kstep; const GAS char* b2 = last ? nB : cB + (size_t)(t + 2) * kstep;
            const GAS char* a3 = a2 + kstep; const GAS char* b3 = b2 + kstep;
            PG8_LDB(B0, 0, 0); PG8_LDB(B1, 0, 1); PG8_SCHED; PG8_LDA(At, 0, 0); PG8_STAGE(PG8_SA(1, 1), a1 + hstepA, voffA);
            PG8_WAIT_V(8); PG8_WAIT_L(0); PG8_BAR; PG8_MMA(0, 0, At, B0); PG8_MMA(0, 1, At, B1); PG8_BAR; PG8_SCHED;
            PG8_LDA(At, 0, 1); PG8_STAGE(PG8_SB(0, 0), b2, voffB); PG8_STAGE(PG8_SB(0, 1), b2 + hstepB, voffB); PG8_STAGE(PG8_SA(0, 0), a2, voffA);
            PG8_WAIT_V(8); PG8_WAIT_L(0); PG8_BAR; PG8_MMA(1, 0, At, B0); PG8_MMA(1, 1, At, B1); PG8_BAR; PG8_SCHED;
            PG8_LDB(B0, 1, 0); PG8_LDB(B1, 1, 1); PG8_SCHED; PG8_LDA(At, 1, 0); PG8_STAGE(PG8_SA(0, 1), a2 + hstepA, voffA);
            PG8_WAIT_V(8); PG8_WAIT_L(0); PG8_BAR; PG8_MMA(0, 0, At, B0); PG8_MMA(0, 1, At, B1); PG8_BAR; PG8_SCHED;
            PG8_LDA(At, 1, 1); PG8_STAGE(PG8_SB(1, 0), b3, voffB); PG8_STAGE(PG8_SB(1, 1), b3 + hstepB, voffB); PG8_STAGE(PG8_SA(1, 0), a3, voffA);
            PG8_WAIT_V(8); PG8_WAIT_L(0); PG8_BAR; PG8_MMA(1, 0, At, B0); PG8_MMA(1, 1, At, B1); PG8_BAR; PG8_SCHED;
        }
        if constexpr (ALIGN_EPI) { if (wr == 0) PG8_BAR; }
        { const int l2 = fresh_lane(); E(acc, cur, wr, wc, l2 & 15, l2 >> 4); }
        if (!has_next) break;
#pragma unroll
        for (int a = 0; a < 2; ++a)
#pragma unroll
            for (int b = 0; b < 2; ++b)
#pragma unroll
                for (int m = 0; m < 4; ++m)
#pragma unroll
                    for (int n = 0; n < 2; ++n) acc[a][b][m][n] = (f32x4){0.f, 0.f, 0.f, 0.f};
        cur = nxt; cA = nA; cB = nB; ++ui;
        if constexpr (ALIGN_EPI) { if (wr == 1) PG8_BAR; }
    }
    PG8_WAIT_V(0);
    if constexpr (!ALIGN_EPI) { if (wr == 0) PG8_BAR; }
    PG8_BAR;
#undef PG8_SA
#undef PG8_SB
#undef PG8_STAGE
#undef PG8_LDA
#undef PG8_LDB
#undef PG8_MMA
#undef PG8_WAIT_V
#undef PG8_WAIT_L
#undef PG8_BAR
#undef PG8_SCHED
}
}
#define XB_TMO      128
#define XB_XCNT(j)  (256  + 64 * (j))
#define XB_XSUB(j)  (1280 + 64 * (j))
#define XB_XGEN(j)  (2304 + 64 * (j))
#define XB_TOP      3328
#define XB_TOPGEN   3392
#define XCD_BAR_WORDS 3456
#define XB_SPIN_CAP (1u << 18)

__device__ __forceinline__ unsigned xb_ld(unsigned* p)              { return __hip_atomic_load(p, __ATOMIC_RELAXED, __HIP_MEMORY_SCOPE_AGENT); }
__device__ __forceinline__ unsigned xb_add(unsigned* p, unsigned v) { return __hip_atomic_fetch_add(p, v, __ATOMIC_RELAXED, __HIP_MEMORY_SCOPE_AGENT); }
__device__ __forceinline__ unsigned xb_xcc_id() { return (unsigned)__builtin_amdgcn_s_getreg((3 << 11) | 20) & 0xFu; }
#define XB_SPIN(cond, bar) do { unsigned _sp = 0; while (cond) { __builtin_amdgcn_s_sleep(1); \
    if ((++_sp & 255u) == 0u) { if (xb_ld(&(bar)[XB_TMO])) break; if (_sp > XB_SPIN_CAP) { atomicAdd(&(bar)[XB_TMO], 1u); break; } } } } while (0)

struct XcdBarrier {
    unsigned* bar; unsigned x;
    volatile LAS unsigned* st;
};

__device__ __forceinline__ XcdBarrier xcd_barrier_post(unsigned* bar, volatile LAS unsigned* st) {
    XcdBarrier b; b.bar = bar; b.x = xb_xcc_id(); b.st = st;
    if (threadIdx.x == 0) (void)xb_add(&bar[XB_XCNT(b.x)], 1u);
    return b;
}
__device__ __forceinline__ void xcd_barrier_complete(unsigned* bar, unsigned x, unsigned& nloc, unsigned& nx) {
    const unsigned G = gridDim.x * gridDim.y * gridDim.z;
    unsigned sum, cnt, mine, sp = 0u;
    for (;;) {
        sum = 0u; cnt = 0u; mine = 0u;
#pragma unroll
        for (unsigned j = 0; j < 16; ++j) { const unsigned c = xb_ld(&bar[XB_XCNT(j)]); sum += c; cnt += (c > 0u) ? 1u : 0u; mine = (j == x) ? c : mine; }
        if (sum == G) break;
        __builtin_amdgcn_s_sleep(1);
        if ((++sp & 255u) == 0u) { if (xb_ld(&bar[XB_TMO])) break; if (sp > XB_SPIN_CAP) { atomicAdd(&bar[XB_TMO], 1u); break; } }
    }
    nloc = mine > 0u ? mine : 1u; nx = cnt > 0u ? cnt : 1u;
}

__device__ __forceinline__ void xcd_barrier(const XcdBarrier& b, const bool t0) {
    asm volatile("s_waitcnt vmcnt(0)" ::: "memory");
    __syncthreads();
    if (t0) {
        unsigned* bar = b.bar;
        __builtin_amdgcn_s_waitcnt(0);
        unsigned nloc = b.st[0], nx = b.st[1];
        if (nloc == 0u) { xcd_barrier_complete(bar, b.x, nloc, nx); b.st[0] = nloc; b.st[1] = nx; }
        const unsigned old = xb_add(&bar[XB_XSUB(b.x)], 1u);
        const unsigned gen = old / nloc;
        if (old + 1u == (gen + 1u) * nloc) {
            __builtin_amdgcn_fence(__ATOMIC_RELEASE, "agent");
            asm volatile("s_waitcnt vmcnt(0)" ::: "memory");
            const unsigned og = xb_add(&bar[XB_TOP], 1u);
            const unsigned tg = og / nx;
            if (og + 1u == (tg + 1u) * nx) xb_add(&bar[XB_TOPGEN], 1u);
            else XB_SPIN(xb_ld(&bar[XB_TOPGEN]) == tg, bar);
            __builtin_amdgcn_fence(__ATOMIC_ACQUIRE, "agent");
            xb_add(&bar[XB_XGEN(b.x)], 1u);
            asm volatile("s_waitcnt vmcnt(0)" ::: "memory");
        } else {
            XB_SPIN(xb_ld(&bar[XB_XGEN(b.x)]) == gen, bar);
            __builtin_amdgcn_fence(__ATOMIC_ACQUIRE, "agent");
            asm volatile("s_waitcnt vmcnt(0)" ::: "memory");
        }
    }
    __syncthreads();
}

constexpr int DM = 1024, MPR = 16384, MSA = 1024, MT = MPR + MSA;
constexpr int NBP = 8, TP = 2048, NBS = 128, TS = 8, NL = 2;
constexpr int DPOOL = 512, DRNN = 1024, DQ = 512, DMIX = 2048, DFF = 3072, NMEM = 256, NHEAD = 4, HDIM = 128;
constexpr int MEMROWS = NBP * NMEM;
constexpr float EPSN = 1e-6f;
constexpr size_t O_Y = 0, O_PPOOL = 17825792, O_PRC = 17948672, O_PRH = 17997824, O_PFC = 18014208, O_PMK = 18112512, O_PMV = 20209664,
                 O_SPOOL = 22306816, O_SRC = 24272896, O_SRH = 25059328, O_SFC = 25321472, O_END = 26894336;
enum { I_XP = 0, I_XS, I_MEM, I_CK, I_CV, I_SPOOL, I_SRC, I_SRH, I_SFC, I_GMIX, I_WIN, I_WGATE, I_BGATE, I_POOLW, I_POOLS, I_RCW, I_RCB, I_RWA, I_RBA, I_RWX, I_RBX,
       I_LAM, I_GMEM, I_WK, I_WV, I_WBP, I_WBR, I_WBA, I_WOUT, I_GFFN, I_WUP, I_FCW, I_FCB, I_WDOWN, I_GFIN, N_IN };

constexpr size_t MiB = 1u << 20;
constexpr size_t WS_CTL = 0, CTL_ZERO_BYTES = 64 * 1024;
constexpr size_t WS_W1 = 1 * MiB;
constexpr size_t WS_WKV = 21 * MiB;
constexpr size_t WS_WBR = 25 * MiB;
constexpr size_t WS_WOUT = 33 * MiB;
constexpr size_t WS_WUP = 37 * MiB;
constexpr size_t WS_WDOWN = 61 * MiB;
constexpr size_t WS_PBD = 73 * MiB;
constexpr size_t WS_RW = 74 * MiB;
constexpr size_t WS_MEMB = 75 * MiB;
constexpr size_t WS_KVB = 79 * MiB;
constexpr size_t WS_VTB = 83 * MiB;
constexpr size_t WS_SSQM = 87 * MiB;
constexpr size_t WS_SSQ1 = 88 * MiB;
constexpr size_t WS_SSQ2 = 90 * MiB;
constexpr size_t WS_AGG = 92 * MiB;
constexpr size_t WS_H = 96 * MiB;
constexpr size_t WS_HB = 164 * MiB;
constexpr size_t WS_R = 198 * MiB;
constexpr size_t WS_Z = WS_R;
constexpr size_t WS_G = WS_R + 68 * MiB;
constexpr size_t WS_DB = WS_R + 170 * MiB;
constexpr size_t WS_XC = WS_R + 187 * MiB;
constexpr size_t WS_PP = WS_R + 221 * MiB;
constexpr size_t WS_MRG = WS_XC;
constexpr size_t WS_MB = WS_R + 255 * MiB;
constexpr size_t WS_GV = WS_R;
constexpr size_t WS_ACT = WS_R + 204 * MiB;
constexpr size_t WS_END = WS_R + 306 * MiB;
static_assert((size_t)MT * 1024 * 2 == 34 * MiB, "row-buffer size");
constexpr int CW_BAR = 4096;

constexpr int RING_OFF = 0, RING_BYTES = 131072;
constexpr int LDSCTL_OFF = RING_BYTES, MISC_OFF = LDSCTL_OFF + 320;
constexpr int LDS_BYTES = 147456;
constexpr int NWAVES = 8, NTHR = 512;

using pg8::cvt_pk_bf16;
__device__ __forceinline__ float bf_lo(unsigned w) { return __uint_as_float(w << 16); }
__device__ __forceinline__ float bf_hi(unsigned w) { return __uint_as_float(w & 0xffff0000u); }
__device__ __forceinline__ float bf1(bf16_t b) { return __uint_as_float((unsigned)b << 16); }
__device__ __forceinline__ f32x4 unpack4(u32x2 w) { return (f32x4){bf_lo(w.x), bf_hi(w.x), bf_lo(w.y), bf_hi(w.y)}; }
__device__ __forceinline__ u32x2 pack4(f32x4 v) { u32x2 w; w.x = cvt_pk_bf16(v[0], v[1]); w.y = cvt_pk_bf16(v[2], v[3]); return w; }
__device__ __forceinline__ u32x4 pack8(f32x4 a, f32x4 b) { u32x4 w; w.x = cvt_pk_bf16(a[0], a[1]); w.y = cvt_pk_bf16(a[2], a[3]); w.z = cvt_pk_bf16(b[0], b[1]); w.w = cvt_pk_bf16(b[2], b[3]); return w; }
__device__ __forceinline__ float sigmoidf_(float x) { return __builtin_amdgcn_rcpf(1.0f + __expf(-x)); }
__device__ __forceinline__ f32x4 sigmoid4(f32x4 v) { return (f32x4){sigmoidf_(v[0]), sigmoidf_(v[1]), sigmoidf_(v[2]), sigmoidf_(v[3])}; }
__device__ __forceinline__ float wave_sum(float v) {
#pragma unroll
    for (int o = 1; o < 64; o <<= 1) v += __shfl_xor(v, o);
    return v;
}
__device__ __forceinline__ float row_rs(const GAS float* ssq, int row, int fq) {
    const f32x4 p = *(const GAS f32x4*)(ssq + (size_t)row * 16 + 4 * fq);
    float s = (p[0] + p[1]) + (p[2] + p[3]);
    s += __shfl_xor(s, 16); s += __shfl_xor(s, 32);
    return rsqrtf(s * (1.0f / 1024.0f) + EPSN);
}

using pg8::Unit;
typedef f32x4 AccT[2][2][4][2];

struct EpiP1 {
    static constexpr bool PERM = true;
    const GAS float* ssq; GAS bf16_t* Z; GAS bf16_t* G; const GAS float* bgate;
    __device__ __forceinline__ void operator()(AccT& acc, const Unit& u, int wr, int wc, int fr, int fq) const {
        const int row0 = u.pm * 256 + wr * 64 + fr;
        const bool isz = u.pn < 8;
        const int col0 = (isz ? u.pn : u.pn - 8) * 256 + wc * 32 + 8 * fq;
        GAS bf16_t* base = isz ? Z : G; const int ld = isz ? DMIX : 3 * DM;
        f32x4 bv[2][2];
#pragma unroll
        for (int bj = 0; bj < 2; ++bj)
#pragma unroll
            for (int n = 0; n < 2; ++n) bv[bj][n] = isz ? (f32x4){0.f, 0.f, 0.f, 0.f} : *(const GAS f32x4*)(bgate + col0 + bj * 128 + 4 * n);
#pragma unroll
        for (int ai = 0; ai < 2; ++ai)
#pragma unroll
            for (int m = 0; m < 4; ++m) {
                int row = row0 + ai * 128 + m * 16; asm volatile("" : "+v"(row)); const float rs = row_rs(ssq, row, fq);
                GAS bf16_t* rowp = base + (size_t)row * ld + col0;
#pragma unroll
                for (int bj = 0; bj < 2; ++bj) {
                    f32x4 v0 = acc[ai][bj][m][0] * rs + bv[bj][0], v1 = acc[ai][bj][m][1] * rs + bv[bj][1];
                    if (!isz) { v0 = sigmoid4(v0); v1 = sigmoid4(v1); }
                    *(GAS u32x4*)(rowp + bj * 128) = pack8(v0, v1);
                }
            }
    }
};
struct EpiKV {
    static constexpr bool PERM = false;
    const GAS float* ssq; GAS float* out; GAS bf16_t* KVB; GAS bf16_t* VTB;
    __device__ __forceinline__ void operator()(AccT& acc, const Unit& u, int wr, int wc, int fr, int fq) const {
        const int t = u.pn >> 1, l = t >> 1; const bool isv = (t & 1) != 0;
        const int row0 = u.pm * 256 + wr * 64 + fr, colb = (u.pn & 1) * 256 + wc * 32 + 4 * fq;
        GAS float* ob = out + (isv ? O_PMV : O_PMK) + (size_t)l * MEMROWS * 512;
#pragma unroll
        for (int ai = 0; ai < 2; ++ai)
#pragma unroll
            for (int m = 0; m < 4; ++m) {
                int row = row0 + ai * 128 + m * 16; asm volatile("" : "+v"(row)); const float rs = row_rs(ssq, row, fq);
#pragma unroll
                for (int bj = 0; bj < 2; ++bj)
#pragma unroll
                    for (int n = 0; n < 2; ++n) {
                        const int c = colb + bj * 128 + 16 * n; const f32x4 v = acc[ai][bj][m][n] * rs;
                        *(GAS f32x4*)(ob + (size_t)row * 512 + c) = v;
                        if (!isv) *(GAS u32x2*)(KVB + ((size_t)l * MEMROWS + row) * 512 + c) = pack4(v);
                        else { const int b = row >> 8, key = row & 255, h = c >> 7, d = c & 127;
                            GAS bf16_t* p = VTB + ((((size_t)l * NBP + b) * NHEAD + h) * HDIM + d) * NMEM + key; const u32x2 w = pack4(v);
                            p[0] = (bf16_t)(w.x & 0xffffu); p[NMEM] = (bf16_t)(w.x >> 16); p[2 * NMEM] = (bf16_t)(w.y & 0xffffu); p[3 * NMEM] = (bf16_t)(w.y >> 16); }
                    }
            }
    }
};
struct EpiPool {
    static constexpr bool PERM = true;
    GAS bf16_t* Z;
    __device__ __forceinline__ void operator()(AccT& acc, const Unit& u, int wr, int wc, int fr, int fq) const {
        const int row0 = u.pm * 256 + wr * 64 + fr, col0 = u.pn * 256 + wc * 32 + 8 * fq;
#pragma unroll
        for (int ai = 0; ai < 2; ++ai)
#pragma unroll
            for (int m = 0; m < 4; ++m) { int row = row0 + ai * 128 + m * 16; asm volatile("" : "+v"(row)); GAS bf16_t* rowp = Z + (size_t)row * DMIX + col0;
#pragma unroll
                for (int bj = 0; bj < 2; ++bj) *(GAS u32x4*)(rowp + bj * 128) = pack8(acc[ai][bj][m][0], acc[ai][bj][m][1]); }
    }
};
struct EpiRnn {
    static constexpr bool PERM = true;
    const GAS float* ba; const GAS float* bx; const GAS bf16_t* XC; GAS bf16_t* Z; GAS bf16_t* PP;
    __device__ __forceinline__ void operator()(AccT& acc, const Unit& u, int wr, int wc, int fr, int fq) const {
        const int row0 = u.pm * 256 + wr * 64 + fr, ch0 = u.pn * 128 + wc * 32 + 8 * fq;
        f32x4 bav[2], bxv[2];
#pragma unroll
        for (int n = 0; n < 2; ++n) { bav[n] = *(const GAS f32x4*)(ba + ch0 + 4 * n); bxv[n] = *(const GAS f32x4*)(bx + ch0 + 4 * n); }
#pragma unroll
        for (int ai = 0; ai < 2; ++ai)
#pragma unroll
            for (int m = 0; m < 4; ++m) {
                int row = row0 + ai * 128 + m * 16; asm volatile("" : "+v"(row));
                const u32x4 xw = *(const GAS u32x4*)(XC + (size_t)row * DRNN + ch0);
                const f32x4 x0 = unpack4((u32x2){xw.x, xw.y}), x1 = unpack4((u32x2){xw.z, xw.w});
                const f32x4 r0 = sigmoid4(acc[ai][0][m][0] + bav[0]), r1 = sigmoid4(acc[ai][0][m][1] + bav[1]);
                const f32x4 i0 = sigmoid4(acc[ai][1][m][0] + bxv[0]), i1 = sigmoid4(acc[ai][1][m][1] + bxv[1]);
                *(GAS u32x4*)(Z + (size_t)row * DMIX + DPOOL + ch0) = pack8(r0, r1);
                *(GAS u32x4*)(PP + (size_t)row * DRNN + ch0) = pack8(i0 * x0, i1 * x1);
                asm volatile("" ::: "memory");
            }
    }
};
template <int SEG> struct EpiMrg {
    static constexpr bool PERM = false;
    const GAS bf16_t* G; GAS float* MRG; GAS bf16_t* MB;
    __device__ __forceinline__ void operator()(AccT& acc, const Unit& u, int wr, int wc, int fr, int fq) const {
        const int row0 = u.pm * 256 + wr * 64 + fr, col0 = u.pn * 256 + wc * 32 + 4 * fq;
#pragma unroll
        for (int ai = 0; ai < 2; ++ai)
#pragma unroll
            for (int m = 0; m < 4; ++m) {
                int row = row0 + ai * 128 + m * 16; asm volatile("" : "+v"(row));
#pragma unroll
                for (int bj = 0; bj < 2; ++bj)
#pragma unroll
                    for (int n = 0; n < 2; ++n) {
                        const int c = col0 + bj * 128 + 16 * n;
                        const f32x4 g = unpack4(*(const GAS u32x2*)(G + (size_t)row * (3 * DM) + SEG * DM + c));
                        f32x4 v = g * acc[ai][bj][m][n]; GAS float* mp = MRG + (size_t)row * DM + c;
                        if (SEG == 0) *(GAS f32x4*)mp = v;
                        else if (SEG == 1) *(GAS f32x4*)mp = *(const GAS f32x4*)mp + v;
                        else { v = v + *(const GAS f32x4*)mp; *(GAS u32x2*)(MB + (size_t)row * DM + c) = pack4(v); }
                    }
                asm volatile("" ::: "memory");
            }
    }
};
struct EpiRes {
    static constexpr bool PERM = false;
    const GAS float* baseP; const GAS float* baseS; GAS float* H; GAS bf16_t* HB; GAS float* ssq_out;
    __device__ __forceinline__ void operator()(AccT& acc, const Unit& u, int wr, int wc, int fr, int fq) const {
        const int row0 = u.pm * 256 + wr * 64 + fr, col0 = u.pn * 256 + wc * 32 + 4 * fq;
#pragma unroll
        for (int ai = 0; ai < 2; ++ai)
#pragma unroll
            for (int m = 0; m < 4; ++m) {
                int row = row0 + ai * 128 + m * 16; asm volatile("" : "+v"(row));
                const GAS float* bp = (row < MPR) ? baseP + (size_t)row * DM : baseS + (size_t)(row - MPR) * DM;
                float ss = 0.f;
#pragma unroll
                for (int bj = 0; bj < 2; ++bj)
#pragma unroll
                    for (int n = 0; n < 2; ++n) {
                        const int c = col0 + bj * 128 + 16 * n;
                        const f32x4 v = *(const GAS f32x4*)(bp + c) + acc[ai][bj][m][n];
                        *(GAS f32x4*)(H + (size_t)row * DM + c) = v; *(GAS u32x2*)(HB + (size_t)row * DM + c) = pack4(v);
                        ss += (v[0] * v[0] + v[1] * v[1]) + (v[2] * v[2] + v[3] * v[3]);
                    }
                ss += __shfl_xor(ss, 16); ss += __shfl_xor(ss, 32);
                if (fq == 0) ssq_out[(size_t)row * 16 + u.pn * 4 + wc] = ss;
                if (m & 1) asm volatile("" ::: "memory");
            }
    }
};
struct EpiUp {
    static constexpr bool PERM = true;
    const GAS float* ssq; GAS bf16_t* GV;
    __device__ __forceinline__ void operator()(AccT& acc, const Unit& u, int wr, int wc, int fr, int fq) const {
        const int row0 = u.pm * 256 + wr * 64 + fr, col0 = u.pn * 256 + wc * 32 + 8 * fq;
#pragma unroll
        for (int ai = 0; ai < 2; ++ai)
#pragma unroll
            for (int m = 0; m < 4; ++m) {
                int row = row0 + ai * 128 + m * 16; asm volatile("" : "+v"(row)); const float rs = row_rs(ssq, row, fq);
                GAS bf16_t* rowp = GV + (size_t)row * (2 * DFF) + col0;
#pragma unroll
                for (int bj = 0; bj < 2; ++bj) *(GAS u32x4*)(rowp + bj * 128) = pack8(acc[ai][bj][m][0] * rs, acc[ai][bj][m][1] * rs);
            }
    }
};

struct Args { const GAS float* in[N_IN]; GAS float* out; GAS unsigned char* ws; int ph_lo, ph_hi; };
struct Ctx {
    LAS unsigned char* lds; int tid, lane, wave, G, bid;
    const GAS float* const CAS* in; GAS float* out; GAS unsigned char* ws;
};
#define WSP(T, off) ((GAS T*)(C.ws + (off)))
__device__ __forceinline__ int opq(int i) { asm volatile("" : "+s"(i)); return i; }

__device__ __forceinline__ void tr_item(const GAS float* W, int ldw, const GAS float* kscale, GAS bf16_t* WT, int ldk, int item, int nblk, LAS float* scr, int lane) {
    const int kb = item / nblk, nb = item % nblk, k0 = 64 * kb, n0 = 32 * nb;
#pragma unroll
    for (int i = 0; i < 8; ++i) { const int kk = 8 * i + (lane >> 3), n4 = (lane & 7) * 4; f32x4 w = *(const GAS f32x4*)(W + (size_t)(k0 + kk) * ldw + n0 + n4); if (kscale) w = w * kscale[k0 + kk];
        LAS float* d = scr + kk * 33 + n4; d[0] = w[0]; d[1] = w[1]; d[2] = w[2]; d[3] = w[3]; }
    LDS_WAIT(); asm volatile("" ::: "memory");
    const int c = lane & 7;
#pragma unroll
    for (int j = 0; j < 4; ++j) { const int n = (lane >> 3) + 8 * j; const LAS float* s = scr + (8 * c) * 33 + n;
        u32x4 o; o.x = cvt_pk_bf16(s[0 * 33], s[1 * 33]); o.y = cvt_pk_bf16(s[2 * 33], s[3 * 33]); o.z = cvt_pk_bf16(s[4 * 33], s[5 * 33]); o.w = cvt_pk_bf16(s[6 * 33], s[7 * 33]);
        *(GAS u32x4*)(WT + (size_t)(n0 + n) * ldk + k0 + 8 * c) = o; }
    LDS_WAIT(); asm volatile("" ::: "memory");
}
__device__ __forceinline__ void row_to_bf16_ssq(const GAS float* xrow, GAS bf16_t* orow, GAS float* ssq16, int lane) {
    const GAS f32x4* xr = (const GAS f32x4*)xrow + lane;
    f32x4 v[4]; float s = 0.f;
#pragma unroll
    for (int j = 0; j < 4; ++j) { v[j] = xr[64 * j]; s += (v[j][0] * v[j][0] + v[j][1] * v[j][1]) + (v[j][2] * v[j][2] + v[j][3] * v[j][3]); }
    s = wave_sum(s);
    GAS u32x2* o8 = (GAS u32x2*)orow + lane;
#pragma unroll
    for (int j = 0; j < 4; ++j) o8[64 * j] = pack4(v[j]);
    if (lane < 16) ssq16[lane] = (lane == 0) ? s : 0.f;
}
__device__ __forceinline__ void phase_prologue(const Ctx& C) {
    LAS float* scr = (LAS float*)(C.lds + RING_OFF + C.wave * 16384);
    const int gw = C.bid * NWAVES + C.wave, NGW = C.G * NWAVES;
    constexpr int PER_L = 9216;
    for (int it = gw; it < 2 * PER_L; it += NGW) {
        const int l = it / PER_L; int r = it % PER_L;
        const GAS float* W; const GAS float* ks = nullptr; GAS bf16_t* dst; int N, ldk;
        if (r < 1024)      { W = C.in[opq(I_WIN)] + (size_t)l * DM * DMIX; N = DMIX; ks = C.in[opq(I_GMIX)] + l * DM; dst = WSP(bf16_t, WS_W1) + (size_t)l * 5120 * DM; ldk = DM; }
        else if (r < 2560) { r -= 1024; W = C.in[opq(I_WGATE)] + (size_t)l * DM * 3 * DM; N = 3 * DM; ks = C.in[opq(I_GMIX)] + l * DM; dst = WSP(bf16_t, WS_W1) + ((size_t)l * 5120 + 2048) * DM; ldk = DM; }
        else if (r < 2816) { r -= 2560; W = C.in[opq(I_WK)] + (size_t)l * DM * DQ; N = DQ; ks = C.in[opq(I_GMEM)] + l * DM; dst = WSP(bf16_t, WS_WKV) + ((size_t)l * 1024) * DM; ldk = DM; }
        else if (r < 3072) { r -= 2816; W = C.in[opq(I_WV)] + (size_t)l * DM * DQ; N = DQ; ks = C.in[opq(I_GMEM)] + l * DM; dst = WSP(bf16_t, WS_WKV) + ((size_t)l * 1024 + 512) * DM; ldk = DM; }
        else if (r < 3328) { r -= 3072; W = C.in[opq(I_WBP)] + (size_t)l * DPOOL * DM; N = DM; dst = WSP(bf16_t, WS_WBR) + (size_t)l * DM * DMIX; ldk = DMIX; }
        else if (r < 3840) { r -= 3328; W = C.in[opq(I_WBR)] + (size_t)l * DRNN * DM; N = DM; dst = WSP(bf16_t, WS_WBR) + (size_t)l * DM * DMIX + 512; ldk = DMIX; }
        else if (r < 4096) { r -= 3840; W = C.in[opq(I_WBA)] + (size_t)l * DQ * DM; N = DM; dst = WSP(bf16_t, WS_WBR) + (size_t)l * DM * DMIX + 1536; ldk = DMIX; }
        else if (r < 4608) { r -= 4096; W = C.in[opq(I_WOUT)] + (size_t)l * DM * DM; N = DM; dst = WSP(bf16_t, WS_WOUT) + (size_t)l * DM * DM; ldk = DM; }
        else if (r < 7680) { r -= 4608; W = C.in[opq(I_WUP)] + (size_t)l * DM * 2 * DFF; N = 2 * DFF; ks = C.in[opq(I_GFFN)] + l * DM; dst = WSP(bf16_t, WS_WUP) + (size_t)l * 2 * DFF * DM; ldk = DM; }
        else               { r -= 7680; W = C.in[opq(I_WDOWN)] + (size_t)l * DFF * DM; N = DM; dst = WSP(bf16_t, WS_WDOWN) + (size_t)l * DM * DFF; ldk = DFF; }
        tr_item(W, N, ks, dst, ldk, r, N / 32, scr, C.lane);
    }
    const int gt = C.bid * NTHR + C.tid, NT = C.G * NTHR;
    {
        GAS bf16_t* PBD = WSP(bf16_t, WS_PBD); const GAS float* pw = C.in[opq(I_POOLW)]; const GAS float* ps = C.in[opq(I_POOLS)];
        for (int i = gt; i < 2 * 2 * 256 * 256; i += NT) {
            const int k = i & 255, n = (i >> 8) & 255, pn = (i >> 16) & 1, l = i >> 17;
            const int gn = 2 * pn + (n >> 7), gk = 2 * pn + (k >> 7);
            float v = 0.f;
            if (gn == gk) v = pw[(((size_t)l * 4 + gn) * 128 + (k & 127)) * 128 + (n & 127)] * ps[l * DPOOL + gn * 128 + (n & 127)];
            PBD[i] = (bf16_t)(cvt_pk_bf16(v, 0.f) & 0xffffu);
        }
        GAS bf16_t* RW = WSP(bf16_t, WS_RW); const GAS float* wa = C.in[opq(I_RWA)]; const GAS float* wx = C.in[opq(I_RWX)];
        for (int i = gt; i < 2 * 8 * 256 * 128; i += NT) {
            const int k = i & 127, n = (i >> 7) & 255, lb = i >> 15;
            const float v = (n < 128) ? wa[((size_t)lb * 128 + k) * 128 + n] : wx[((size_t)lb * 128 + k) * 128 + (n - 128)];
            RW[i] = (bf16_t)(cvt_pk_bf16(v, 0.f) & 0xffffu);
        }
    }
    for (int m = gw; m < MT + MEMROWS; m += NGW) {
        if (m < MT) { const GAS float* xr = (m < MPR) ? C.in[opq(I_XP)] + (size_t)m * DM : C.in[opq(I_XS)] + (size_t)(m - MPR) * DM;
            row_to_bf16_ssq(xr, WSP(bf16_t, WS_HB) + (size_t)m * DM, WSP(float, WS_SSQ1) + (size_t)m * 16, C.lane); }
        else { const int r = m - MT; row_to_bf16_ssq(C.in[opq(I_MEM)] + (size_t)r * DM, WSP(bf16_t, WS_MEMB) + (size_t)r * DM, WSP(float, WS_SSQM) + (size_t)r * 16, C.lane); }
    }
}

constexpr float ATT_C = 0.08838834764831845f * 1.4426950408889634f;
__device__ __forceinline__ void attn16_full(const GAS bf16_t* qrow, const GAS bf16_t* Kb, int ldk, const GAS bf16_t* VT, GAS bf16_t* orow, int lane) {
    const int q = lane & 15, g = lane >> 4;
    bf16x8 qf[4];
#pragma unroll
    for (int ks = 0; ks < 4; ++ks) qf[ks] = *(const GAS bf16x8*)(qrow + 32 * ks + 8 * g);
    f32x4 s[16];
    const GAS bf16_t* kr = Kb + (size_t)q * ldk + 8 * g;
#pragma unroll
    for (int t = 0; t < 16; ++t) {
        asm volatile("" : "+v"(kr));
        f32x4 a = (f32x4){0.f, 0.f, 0.f, 0.f};
#pragma unroll
        for (int ks = 0; ks < 4; ++ks) a = __builtin_amdgcn_mfma_f32_16x16x32_bf16(*(const GAS bf16x8*)(kr + 32 * ks), qf[ks], a, 0, 0, 0);
        s[t] = a;
        kr += (size_t)16 * ldk;
    }
    float mx = -3.0e38f;
#pragma unroll
    for (int t = 0; t < 16; ++t) mx = fmaxf(fmaxf(fmaxf(mx, s[t][0]), fmaxf(s[t][1], s[t][2])), s[t][3]);
    mx = fmaxf(mx, __shfl_xor(mx, 16)); mx = fmaxf(mx, __shfl_xor(mx, 32));
    float sum = 0.f;
#pragma unroll
    for (int t = 0; t < 16; ++t)
#pragma unroll
        for (int r = 0; r < 4; ++r) { const float p = __builtin_amdgcn_exp2f((s[t][r] - mx) * ATT_C); s[t][r] = p; sum += p; }
    sum += __shfl_xor(sum, 16); sum += __shfl_xor(sum, 32);
    const float inv = 1.0f / sum;
    bf16x8 pf[8];
#pragma unroll
    for (int ks = 0; ks < 8; ++ks) { const u32x4 w = pack8(s[2 * ks], s[2 * ks + 1]); pf[ks] = __builtin_bit_cast(bf16x8, w); }
    const GAS bf16_t* vr = VT + (size_t)q * NMEM + 4 * g; GAS bf16_t* op = orow + 4 * g;
#pragma unroll
    for (int nt = 0; nt < 8; ++nt) {
        asm volatile("" : "+v"(vr), "+v"(op));
        f32x4 o = (f32x4){0.f, 0.f, 0.f, 0.f};
#pragma unroll
        for (int ks = 0; ks < 8; ++ks) {
            const u32x2 lo = *(const GAS u32x2*)(vr + 32 * ks), hi = *(const GAS u32x2*)(vr + 32 * ks + 16);
            const u32x4 w = (u32x4){lo.x, lo.y, hi.x, hi.y};
            o = __builtin_amdgcn_mfma_f32_16x16x32_bf16(__builtin_bit_cast(bf16x8, w), pf[ks], o, 0, 0, 0);
        }
        *(GAS u32x2*)op = pack4(o * inv);
        vr += 16 * NMEM; op += 16;
    }
}
__device__ __forceinline__ void phase_attention(const Ctx& C, int l) {
    GAS bf16_t* Z = WSP(bf16_t, WS_Z);
    for (int id = C.bid; id < 256; id += C.G) {
        const int x = id & 7, j = id >> 3, pair = x * 4 + (j & 3), qb = j >> 2, b = pair >> 2, h = pair & 3;
        const GAS bf16_t* Kb = WSP(bf16_t, WS_KVB) + ((size_t)l * MEMROWS + b * NMEM) * 512 + h * HDIM;
        const GAS bf16_t* VT = WSP(bf16_t, WS_VTB) + (((size_t)l * NBP + b) * NHEAD + h) * HDIM * NMEM;
#pragma unroll 1
        for (int kb = 0; kb < 2; ++kb) {
            const int row = b * TP + qb * 256 + C.wave * 32 + kb * 16 + (C.lane & 15);
            GAS bf16_t* qp = Z + (size_t)row * DMIX + (DPOOL + DRNN) + h * HDIM;
            attn16_full(qp, Kb, 512, VT, qp, C.lane);
        }
    }
    LAS float* ML = (LAS float*)(C.lds + RING_OFF);
    LAS float* OP = (LAS float*)(C.lds + RING_OFF + 1024);
    for (int id = C.bid; id < NBS * NHEAD; id += C.G) {
        const int b = id >> 2, h = id & 3, w = C.wave, q = C.lane & 15, g = C.lane >> 4;
        const GAS float* Kc = C.in[opq(I_CK)] + ((((size_t)l * NBS + b) * NMEM) * NHEAD + h) * HDIM;
        const GAS float* Vc = C.in[opq(I_CV)] + ((((size_t)l * NBS + b) * NMEM) * NHEAD + h) * HDIM;
        const GAS bf16_t* qrow = Z + (size_t)(MPR + b * TS + (q & 7)) * DMIX + (DPOOL + DRNN) + h * HDIM;
        bf16x8 qf[4];
#pragma unroll
        for (int ks = 0; ks < 4; ++ks) qf[ks] = *(const GAS bf16x8*)(qrow + 32 * ks + 8 * g);
        f32x4 s[2];
#pragma unroll
        for (int t = 0; t < 2; ++t) {
            f32x4 a = (f32x4){0.f, 0.f, 0.f, 0.f}; const GAS float* kr = Kc + (size_t)(32 * w + 16 * t + q) * (NHEAD * HDIM) + 8 * g;
#pragma unroll
            for (int ks = 0; ks < 4; ++ks) { const u32x4 kw = pack8(*(const GAS f32x4*)(kr + 32 * ks), *(const GAS f32x4*)(kr + 32 * ks + 4));
                a = __builtin_amdgcn_mfma_f32_16x16x32_bf16(__builtin_bit_cast(bf16x8, kw), qf[ks], a, 0, 0, 0); }
            s[t] = a;
        }
        float mx = fmaxf(fmaxf(fmaxf(s[0][0], s[0][1]), fmaxf(s[0][2], s[0][3])), fmaxf(fmaxf(s[1][0], s[1][1]), fmaxf(s[1][2], s[1][3])));
        mx = fmaxf(mx, __shfl_xor(mx, 16)); mx = fmaxf(mx, __shfl_xor(mx, 32));
        float sum = 0.f;
#pragma unroll
        for (int t = 0; t < 2; ++t)
#pragma unroll
            for (int r = 0; r < 4; ++r) { const float p = __builtin_amdgcn_exp2f((s[t][r] - mx) * ATT_C); s[t][r] = p; sum += p; }
        sum += __shfl_xor(sum, 16); sum += __shfl_xor(sum, 32);
        const u32x4 pw = pack8(s[0], s[1]); const bf16x8 pf = __builtin_bit_cast(bf16x8, pw);
        if (g == 0) { ML[(w * 16 + q) * 2 + 0] = mx; ML[(w * 16 + q) * 2 + 1] = sum; }
        const GAS float* vr = Vc + (size_t)(32 * w + 4 * g) * (NHEAD * HDIM) + q;
#pragma unroll
        for (int nt = 0; nt < 8; ++nt) {
            asm volatile("" : "+v"(vr));
            const GAS float* v0p = vr; const GAS float* v1p = vr + 2 * (NHEAD * HDIM); const GAS float* v2p = vr + 16 * (NHEAD * HDIM); const GAS float* v3p = vr + 18 * (NHEAD * HDIM);
            float v[8];
            v[0] = v0p[0]; v[1] = v0p[NHEAD * HDIM]; v[2] = v1p[0]; v[3] = v1p[NHEAD * HDIM];
            v[4] = v2p[0]; v[5] = v2p[NHEAD * HDIM]; v[6] = v3p[0]; v[7] = v3p[NHEAD * HDIM];
            vr += 16;
            u32x4 vw; vw.x = cvt_pk_bf16(v[0], v[1]); vw.y = cvt_pk_bf16(v[2], v[3]); vw.z = cvt_pk_bf16(v[4], v[5]); vw.w = cvt_pk_bf16(v[6], v[7]);
            const f32x4 o = __builtin_amdgcn_mfma_f32_16x16x32_bf16(__builtin_bit_cast(bf16x8, vw), pf, (f32x4){0.f, 0.f, 0.f, 0.f}, 0, 0, 0);
            if (q < 8) *(LAS f32x4*)(OP + (w * 8 + q) * 128 + 16 * nt + 4 * g) = o;
        }
        __syncthreads();
        {
            const int qo = C.tid >> 6, d2 = (C.tid & 63) * 2;
            float mw[8], M = -3.0e38f;
#pragma unroll
            for (int ww = 0; ww < 8; ++ww) { mw[ww] = ML[(ww * 16 + qo) * 2]; M = fmaxf(M, mw[ww]); }
            float L = 0.f, o0 = 0.f, o1 = 0.f;
#pragma unroll
            for (int ww = 0; ww < 8; ++ww) { const float f = __builtin_amdgcn_exp2f((mw[ww] - M) * ATT_C); L += f * ML[(ww * 16 + qo) * 2 + 1];
                const f32x2 ov = *(const LAS f32x2*)(OP + (ww * 8 + qo) * 128 + d2); o0 += f * ov[0]; o1 += f * ov[1]; }
            const float inv = 1.0f / L;
            *(GAS unsigned*)(Z + (size_t)(MPR + b * TS + qo) * DMIX + (DPOOL + DRNN) + h * HDIM + d2) = cvt_pk_bf16(o0 * inv, o1 * inv);
        }
        __syncthreads();
    }
}

__device__ __forceinline__ void ld8(const GAS bf16_t* p, float (&v)[8]) { const u32x4 w = *(const GAS u32x4*)p; v[0] = bf_lo(w.x); v[1] = bf_hi(w.x); v[2] = bf_lo(w.y); v[3] = bf_hi(w.y); v[4] = bf_lo(w.z); v[5] = bf_hi(w.z); v[6] = bf_lo(w.w); v[7] = bf_hi(w.w); }
__device__ __forceinline__ void ld8f(const GAS float* p, float (&v)[8]) { const f32x4 a = *(const GAS f32x4*)p, b = *(const GAS f32x4*)(p + 4); v[0] = a[0]; v[1] = a[1]; v[2] = a[2]; v[3] = a[3]; v[4] = b[0]; v[5] = b[1]; v[6] = b[2]; v[7] = b[3]; }
__device__ __forceinline__ void st8(GAS bf16_t* p, const float (&v)[8]) { u32x4 w; w.x = cvt_pk_bf16(v[0], v[1]); w.y = cvt_pk_bf16(v[2], v[3]); w.z = cvt_pk_bf16(v[4], v[5]); w.w = cvt_pk_bf16(v[6], v[7]); *(GAS u32x4*)p = w; }
__device__ __forceinline__ void st8f(GAS float* p, const float (&v)[8]) { *(GAS f32x4*)p = (f32x4){v[0], v[1], v[2], v[3]}; *(GAS f32x4*)(p + 4) = (f32x4){v[4], v[5], v[6], v[7]}; }

__device__ __forceinline__ void phase_mix_elem(const Ctx& C, int l) {
    const GAS bf16_t* Z = WSP(bf16_t, WS_Z); GAS bf16_t* DBf = WSP(bf16_t, WS_DB); GAS bf16_t* XC = WSP(bf16_t, WS_XC);
    const GAS float* spool = C.in[opq(I_SPOOL)] + (size_t)l * NBS * 15 * DPOOL; const GAS float* srconv = C.in[opq(I_SRC)] + (size_t)l * NBS * 3 * DRNN;
    const GAS float* cw = C.in[opq(I_RCW)] + (size_t)l * 4 * DRNN; const GAS float* cb = C.in[opq(I_RCB)] + (size_t)l * DRNN;
    GAS float* out = C.out;
    const long total = (long)MT * 192;
    for (long idx = (long)C.bid * NTHR + C.tid; idx < total; idx += (long)C.G * NTHR) {
        const int m = (int)(idx / 192), c8 = (int)(idx % 192);
        const bool pr = m < MPR; const int b = pr ? (m >> 11) : ((m - MPR) >> 3), t = pr ? (m & 2047) : ((m - MPR) & 7);
        if (c8 < 64) {
            const int ch = c8 * 8, g = ch >> 7, w = 2 << g;
            float u[8], sum[8]; ld8(Z + (size_t)m * DMIX + ch, u);
#pragma unroll
            for (int i = 0; i < 8; ++i) sum[i] = u[i];
            for (int j = 1; j < w; ++j) { const int tt = t - j; float v[8];
                if (tt >= 0) { ld8(Z + (size_t)(m - j) * DMIX + ch, v); } else if (!pr) { ld8f(spool + ((size_t)b * 15 + (15 + tt)) * DPOOL + ch, v); } else break;
#pragma unroll
                for (int i = 0; i < 8; ++i) sum[i] += v[i]; }
            const float cnt = pr ? (float)((t + 1 < w) ? t + 1 : w) : (float)w; const float ic = 1.0f / cnt;
            float d[8];
#pragma unroll
            for (int i = 0; i < 8; ++i) d[i] = sum[i] * ic - u[i];
            st8(DBf + (size_t)m * DPOOL + ch, d);
            if (pr) { if (t >= TP - 15) st8f(out + O_PPOOL + (((size_t)l * NBP + b) * 15 + (t - (TP - 15))) * DPOOL + ch, u); }
            else { st8f(out + O_SPOOL + (((size_t)l * NBS + b) * 15 + 7 + t) * DPOOL + ch, u);
                if (t == 0) for (int j = 0; j < 7; ++j) { float v[8]; ld8f(spool + ((size_t)b * 15 + j + 8) * DPOOL + ch, v); st8f(out + O_SPOOL + (((size_t)l * NBS + b) * 15 + j) * DPOOL + ch, v); } }
        } else {
            const int ch = (c8 - 64) * 8;
            float x[8], u[8]; ld8f(cb + ch, x);
#pragma unroll
            for (int j = 0; j < 4; ++j) { const int tt = t + j - 3; float v[8], wj[8]; bool have = true;
                if (tt >= 0) ld8(Z + (size_t)(m + j - 3) * DMIX + DPOOL + ch, v); else if (!pr) ld8f(srconv + ((size_t)b * 3 + (3 + tt)) * DRNN + ch, v); else have = false;
                if (have) { ld8f(cw + (size_t)j * DRNN + ch, wj);
#pragma unroll
                    for (int i = 0; i < 8; ++i) x[i] += wj[i] * v[i]; }
                if (j == 3) {
#pragma unroll
                    for (int i = 0; i < 8; ++i) u[i] = v[i]; } }
            st8(XC + (size_t)m * DRNN + ch, x);
            if (pr) { if (t >= TP - 3) st8f(out + O_PRC + (((size_t)l * NBP + b) * 3 + (t - (TP - 3))) * DRNN + ch, u); }
            else { if (t >= TS - 3) st8f(out + O_SRC + (((size_t)l * NBS + b) * 3 + (t - (TS - 3))) * DRNN + ch, u); }
        }
    }
}

__device__ __forceinline__ void scan_coef(const GAS float* lam, int ch, float (&nl)[4]) {
#pragma unroll
    for (int i = 0; i < 4; ++i) { const float x = -lam[ch + i]; const float sp = fmaxf(x, 0.f) + log1pf(__expf(-fabsf(x))); nl[i] = -8.0f * 1.4426950408889634f * sp; }
}
__device__ __forceinline__ void scan_step(const GAS bf16_t* Zr, const GAS bf16_t* Pr, const float (&nl)[4], float (&h)[4], float (*A)[4]) {
    const f32x4 r = unpack4(*(const GAS u32x2*)Zr), p = unpack4(*(const GAS u32x2*)Pr);
#pragma unroll
    for (int i = 0; i < 4; ++i) { const float a = __builtin_amdgcn_exp2f(r[i] * nl[i]); const float beta = __builtin_amdgcn_sqrtf(fmaxf(1.0f - a * a, 0.f));
        h[i] = a * h[i] + beta * p[i]; if (A) (*A)[i] *= a; }
}
__device__ __forceinline__ void phase_scan_a(const Ctx& C, int l) {
    GAS bf16_t* Z = WSP(bf16_t, WS_Z); const GAS bf16_t* PP = WSP(bf16_t, WS_PP); GAS float* AGG = WSP(float, WS_AGG);
    const GAS float* lam = C.in[opq(I_LAM)] + (size_t)l * DRNN;
    for (int gt = C.bid * NTHR + C.tid; gt < NBP * 64 * 256; gt += C.G * NTHR) {
        const int unit = gt >> 8, ch = (gt & 255) * 4, b = unit >> 6, c = unit & 63;
        float nl[4]; scan_coef(lam, ch, nl);
        float h[4] = {0.f, 0.f, 0.f, 0.f}, A[4] = {1.f, 1.f, 1.f, 1.f};
        const size_t row0 = (size_t)b * TP + c * 32;
#pragma unroll 4
        for (int t = 0; t < 32; ++t) scan_step(Z + (row0 + t) * DMIX + DPOOL + ch, PP + (row0 + t) * DRNN + ch, nl, h, &A);
        *(GAS f32x4*)(AGG + ((size_t)(b * 64 + c)) * DRNN + ch) = (f32x4){A[0], A[1], A[2], A[3]};
        *(GAS f32x4*)(AGG + (size_t)NBP * 64 * DRNN + ((size_t)(b * 64 + c)) * DRNN + ch) = (f32x4){h[0], h[1], h[2], h[3]};
    }
    for (int gt = C.bid * NTHR + C.tid; gt < NBS * 256; gt += C.G * NTHR) {
        const int b = gt >> 8, ch = (gt & 255) * 4;
        float nl[4]; scan_coef(lam, ch, nl);
        const f32x4 h0 = *(const GAS f32x4*)(C.in[opq(I_SRH)] + ((size_t)l * NBS + b) * DRNN + ch);
        float h[4] = {h0[0], h0[1], h0[2], h0[3]};
        const size_t row0 = (size_t)MPR + b * TS;
#pragma unroll
        for (int t = 0; t < TS; ++t) { scan_step(Z + (row0 + t) * DMIX + DPOOL + ch, PP + (row0 + t) * DRNN + ch, nl, h, nullptr);
            *(GAS u32x2*)(Z + (row0 + t) * DMIX + DPOOL + ch) = pack4((f32x4){h[0], h[1], h[2], h[3]}); }
        *(GAS f32x4*)(C.out + O_SRH + ((size_t)l * NBS + b) * DRNN + ch) = (f32x4){h[0], h[1], h[2], h[3]};
    }
}
__device__ __forceinline__ void phase_scan_b(const Ctx& C, int l) {
    GAS bf16_t* Z = WSP(bf16_t, WS_Z); const GAS bf16_t* PP = WSP(bf16_t, WS_PP); const GAS float* AGG = WSP(float, WS_AGG);
    const GAS float* lam = C.in[opq(I_LAM)] + (size_t)l * DRNN;
    for (int gt = C.bid * NTHR + C.tid; gt < NBP * 64 * 256; gt += C.G * NTHR) {
        const int unit = gt >> 8, ch = (gt & 255) * 4, b = unit >> 6, c = unit & 63;
        float nl[4]; scan_coef(lam, ch, nl);
        float h[4] = {0.f, 0.f, 0.f, 0.f};
        for (int cc = 0; cc < c; ++cc) {
            const f32x4 a = *(const GAS f32x4*)(AGG + ((size_t)(b * 64 + cc)) * DRNN + ch), bb = *(const GAS f32x4*)(AGG + (size_t)NBP * 64 * DRNN + ((size_t)(b * 64 + cc)) * DRNN + ch);
#pragma unroll
            for (int i = 0; i < 4; ++i) h[i] = a[i] * h[i] + bb[i];
        }
        const size_t row0 = (size_t)b * TP + c * 32;
#pragma unroll 4
        for (int t = 0; t < 32; ++t) { scan_step(Z + (row0 + t) * DMIX + DPOOL + ch, PP + (row0 + t) * DRNN + ch, nl, h, nullptr);
            *(GAS u32x2*)(Z + (row0 + t) * DMIX + DPOOL + ch) = pack4((f32x4){h[0], h[1], h[2], h[3]}); }
        if (c == 63) *(GAS f32x4*)(C.out + O_PRH + ((size_t)l * NBP + b) * DRNN + ch) = (f32x4){h[0], h[1], h[2], h[3]};
    }
}

__device__ __forceinline__ float gelu_tanh(float x) { const float y = 0.7978845608028654f * (x + 0.044715f * x * x * x); return x * sigmoidf_(2.0f * y); }
__device__ __forceinline__ void phase_ffn_elem(const Ctx& C, int l) {
    const GAS bf16_t* GV = WSP(bf16_t, WS_GV); GAS bf16_t* ACT = WSP(bf16_t, WS_ACT);
    const GAS float* sfc = C.in[opq(I_SFC)] + (size_t)l * NBS * 2 * DFF; const GAS float* cw = C.in[opq(I_FCW)] + (size_t)l * 3 * DFF; const GAS float* cb = C.in[opq(I_FCB)] + (size_t)l * DFF;
    GAS float* out = C.out;
    const long total = (long)MT * 384;
    for (long idx = (long)C.bid * NTHR + C.tid; idx < total; idx += (long)C.G * NTHR) {
        const int m = (int)(idx / 384), ch = (int)(idx % 384) * 8;
        const bool pr = m < MPR; const int b = pr ? (m >> 11) : ((m - MPR) >> 3), t = pr ? (m & 2047) : ((m - MPR) & 7);
        float x[8], gp[8], val[8]; ld8f(cb + ch, x);
#pragma unroll
        for (int j = 0; j < 3; ++j) { const int tt = t + j - 2; float v[8], wj[8]; bool have = true;
            if (tt >= 0) ld8(GV + (size_t)(m + j - 2) * (2 * DFF) + ch, v); else if (!pr) ld8f(sfc + ((size_t)b * 2 + (2 + tt)) * DFF + ch, v); else have = false;
            if (have) { ld8f(cw + (size_t)j * DFF + ch, wj);
#pragma unroll
                for (int i = 0; i < 8; ++i) x[i] += wj[i] * v[i]; }
            if (j == 2) {
#pragma unroll
                for (int i = 0; i < 8; ++i) gp[i] = v[i]; } }
        ld8(GV + (size_t)m * (2 * DFF) + DFF + ch, val);
        float a[8];
#pragma unroll
        for (int i = 0; i < 8; ++i) a[i] = gelu_tanh(x[i]) * val[i];
        st8(ACT + (size_t)m * DFF + ch, a);
        if (pr) { if (t >= TP - 2) st8f(out + O_PFC + (((size_t)l * NBP + b) * 2 + (t - (TP - 2))) * DFF + ch, gp); }
        else { if (t >= TS - 2) st8f(out + O_SFC + (((size_t)l * NBS + b) * 2 + (t - (TS - 2))) * DFF + ch, gp); }
    }
}

__device__ __forceinline__ void phase_final(const Ctx& C) {
    const GAS float* H = WSP(float, WS_H); const GAS float* ssq = WSP(float, WS_SSQ1); const GAS float* gf = C.in[opq(I_GFIN)];
    const int gw = C.bid * NWAVES + C.wave, NGW = C.G * NWAVES;
    for (int m = gw; m < MT; m += NGW) {
        const GAS f32x4* sp = (const GAS f32x4*)(ssq + (size_t)m * 16);
        const f32x4 p0 = sp[0], p1 = sp[1], p2 = sp[2], p3 = sp[3];
        const float s = ((p0[0] + p0[1]) + (p0[2] + p0[3])) + ((p1[0] + p1[1]) + (p1[2] + p1[3])) + ((p2[0] + p2[1]) + (p2[2] + p2[3])) + ((p3[0] + p3[1]) + (p3[2] + p3[3]));
        const float rs = rsqrtf(s * (1.0f / 1024.0f) + EPSN);
        const GAS f32x4* hr = (const GAS f32x4*)(H + (size_t)m * DM) + C.lane; const GAS f32x4* gr = (const GAS f32x4*)gf + C.lane; GAS f32x4* orow = (GAS f32x4*)(C.out + O_Y + (size_t)m * DM) + C.lane;
#pragma unroll
        for (int j = 0; j < 4; ++j) orow[64 * j] = hr[64 * j] * rs * gr[64 * j];
    }
}

#ifndef OPT_FFN
#define OPT_FFN 1
#endif
#ifndef OPT_MIX
#define OPT_MIX 1
#endif
#ifndef OPT_ATTN
#define OPT_ATTN 1
#endif

__device__ __forceinline__ void phase_ffn_elem2(const Ctx& C, int l) {
    const GAS bf16_t* GV = WSP(bf16_t, WS_GV); GAS bf16_t* ACT = WSP(bf16_t, WS_ACT);
    const GAS float* sfc = C.in[opq(I_SFC)] + (size_t)l * NBS * 2 * DFF; const GAS float* cw = C.in[opq(I_FCW)] + (size_t)l * 3 * DFF; const GAS float* cb = C.in[opq(I_FCB)] + (size_t)l * DFF;
    GAS float* out = C.out;
    const int total = (MT / 8) * 384;
    for (int idx = C.bid * NTHR + C.tid; idx < total; idx += C.G * NTHR) {
        const int run = idx / 384, ch = (idx - run * 384) * 8, m0 = run * 8;
        const bool pr = m0 < MPR; const int b = pr ? (m0 >> 11) : ((m0 - MPR) >> 3), t0 = pr ? (m0 & 2047) : 0;
        float bia[8], w0[8], w1[8], w2[8], gm2[8], gm1[8];
        ld8f(cb + ch, bia); ld8f(cw + ch, w0); ld8f(cw + DFF + ch, w1); ld8f(cw + 2 * DFF + ch, w2);
        if (pr) { if (t0 >= 2) { ld8(GV + (size_t)(m0 - 2) * (2 * DFF) + ch, gm2); ld8(GV + (size_t)(m0 - 1) * (2 * DFF) + ch, gm1); }
                  else {
#pragma unroll
                      for (int i = 0; i < 8; ++i) { gm2[i] = 0.f; gm1[i] = 0.f; } } }
        else { ld8f(sfc + ((size_t)b * 2 + 0) * DFF + ch, gm2); ld8f(sfc + ((size_t)b * 2 + 1) * DFF + ch, gm1); }
        u32x4 gw[8], vw[8];
#pragma unroll
        for (int r = 0; r < 8; ++r) { gw[r] = *(const GAS u32x4*)(GV + (size_t)(m0 + r) * (2 * DFF) + ch); vw[r] = *(const GAS u32x4*)(GV + (size_t)(m0 + r) * (2 * DFF) + DFF + ch); }
#pragma unroll
        for (int r = 0; r < 8; ++r) {
            float g[8], v[8], a[8];
            g[0] = bf_lo(gw[r].x); g[1] = bf_hi(gw[r].x); g[2] = bf_lo(gw[r].y); g[3] = bf_hi(gw[r].y); g[4] = bf_lo(gw[r].z); g[5] = bf_hi(gw[r].z); g[6] = bf_lo(gw[r].w); g[7] = bf_hi(gw[r].w);
            v[0] = bf_lo(vw[r].x); v[1] = bf_hi(vw[r].x); v[2] = bf_lo(vw[r].y); v[3] = bf_hi(vw[r].y); v[4] = bf_lo(vw[r].z); v[5] = bf_hi(vw[r].z); v[6] = bf_lo(vw[r].w); v[7] = bf_hi(vw[r].w);
#pragma unroll
            for (int i = 0; i < 8; ++i) { const float x = bia[i] + w0[i] * gm2[i] + w1[i] * gm1[i] + w2[i] * g[i]; a[i] = gelu_tanh(x) * v[i]; gm2[i] = gm1[i]; gm1[i] = g[i]; }
            st8(ACT + (size_t)(m0 + r) * DFF + ch, a);
            if (r >= 6) {
                if (pr) { if (t0 == TP - 8) st8f(out + O_PFC + (((size_t)l * NBP + b) * 2 + (r - 6)) * DFF + ch, g); }
                else st8f(out + O_SFC + (((size_t)l * NBS + b) * 2 + (r - 6)) * DFF + ch, g);
            }
        }
    }
}

__device__ __forceinline__ void phase_mix_elem2(const Ctx& C, int l) {
    const GAS bf16_t* Z = WSP(bf16_t, WS_Z); GAS bf16_t* DBf = WSP(bf16_t, WS_DB); GAS bf16_t* XC = WSP(bf16_t, WS_XC);
    const GAS float* spool = C.in[opq(I_SPOOL)] + (size_t)l * NBS * 15 * DPOOL; const GAS float* srconv = C.in[opq(I_SRC)] + (size_t)l * NBS * 3 * DRNN;
    const GAS float* cw = C.in[opq(I_RCW)] + (size_t)l * 4 * DRNN; const GAS float* cb = C.in[opq(I_RCB)] + (size_t)l * DRNN;
    GAS float* out = C.out;
    const int totalP = (MPR / 32) * 192;
    for (int idx = C.bid * NTHR + C.tid; idx < totalP; idx += C.G * NTHR) {
        const int run = idx / 192, c8 = idx - run * 192, m0 = run * 32, b = m0 >> 11, t0 = m0 & 2047;
        if (c8 < 64) {
            const int ch = c8 * 8, g = ch >> 7, w = 2 << g;
            float sum[8];
#pragma unroll
            for (int i = 0; i < 8; ++i) sum[i] = 0.f;
            for (int j = 1; j < w; ++j) { if (t0 - j < 0) break; float v[8]; ld8(Z + (size_t)(m0 - j) * DMIX + ch, v);
#pragma unroll
                for (int i = 0; i < 8; ++i) sum[i] += v[i]; }
            const float iw = 1.0f / (float)w;
#pragma unroll 4
            for (int r = 0; r < 32; ++r) {
                const int t = t0 + r; float u[8], d[8]; ld8(Z + (size_t)(m0 + r) * DMIX + ch, u);
                const float ic = (t + 1 < w) ? 1.0f / (float)(t + 1) : iw;
#pragma unroll
                for (int i = 0; i < 8; ++i) { sum[i] += u[i]; d[i] = sum[i] * ic - u[i]; }
                st8(DBf + (size_t)(m0 + r) * DPOOL + ch, d);
                if (t - w + 1 >= 0) { float o[8]; ld8(Z + (size_t)(m0 + r - w + 1) * DMIX + ch, o);
#pragma unroll
                    for (int i = 0; i < 8; ++i) sum[i] -= o[i]; }
                if (t >= TP - 15) st8f(out + O_PPOOL + (((size_t)l * NBP + b) * 15 + (t - (TP - 15))) * DPOOL + ch, u);
            }
        } else {
            const int ch = (c8 - 64) * 8;
            float bia[8], w0[8], w1[8], w2[8], w3[8], x3[8], x2[8], x1[8];
            ld8f(cb + ch, bia); ld8f(cw + ch, w0); ld8f(cw + DRNN + ch, w1); ld8f(cw + 2 * DRNN + ch, w2); ld8f(cw + 3 * DRNN + ch, w3);
            if (t0 >= 3) { ld8(Z + (size_t)(m0 - 3) * DMIX + DPOOL + ch, x3); ld8(Z + (size_t)(m0 - 2) * DMIX + DPOOL + ch, x2); ld8(Z + (size_t)(m0 - 1) * DMIX + DPOOL + ch, x1); }
            else {
#pragma unroll
                for (int i = 0; i < 8; ++i) { x3[i] = 0.f; x2[i] = 0.f; x1[i] = 0.f; } }
#pragma unroll 4
            for (int r = 0; r < 32; ++r) {
                const int t = t0 + r; float u[8], x[8]; ld8(Z + (size_t)(m0 + r) * DMIX + DPOOL + ch, u);
#pragma unroll
                for (int i = 0; i < 8; ++i) { x[i] = bia[i] + w0[i] * x3[i] + w1[i] * x2[i] + w2[i] * x1[i] + w3[i] * u[i]; x3[i] = x2[i]; x2[i] = x1[i]; x1[i] = u[i]; }
                st8(XC + (size_t)(m0 + r) * DRNN + ch, x);
                if (t >= TP - 3) st8f(out + O_PRC + (((size_t)l * NBP + b) * 3 + (t - (TP - 3))) * DRNN + ch, u);
            }
        }
    }
    const int totalS = MSA * 192;
    for (int idx = C.bid * NTHR + C.tid; idx < totalS; idx += C.G * NTHR) {
        const int ms = idx / 192, c8 = idx - ms * 192, m = MPR + ms, b = ms >> 3, t = ms & 7;
        if (c8 < 64) {
            const int ch = c8 * 8, g = ch >> 7, w = 2 << g;
            float u[8], sum[8]; ld8(Z + (size_t)m * DMIX + ch, u);
#pragma unroll
            for (int i = 0; i < 8; ++i) sum[i] = u[i];
            for (int j = 1; j < w; ++j) { const int tt = t - j; float v[8];
                if (tt >= 0) ld8(Z + (size_t)(m - j) * DMIX + ch, v); else ld8f(spool + ((size_t)b * 15 + (15 + tt)) * DPOOL + ch, v);
#pragma unroll
                for (int i = 0; i < 8; ++i) sum[i] += v[i]; }
            const float ic = 1.0f / (float)w; float d[8];
#pragma unroll
            for (int i = 0; i < 8; ++i) d[i] = sum[i] * ic - u[i];
            st8(DBf + (size_t)m * DPOOL + ch, d);
            st8f(out + O_SPOOL + (((size_t)l * NBS + b) * 15 + 7 + t) * DPOOL + ch, u);
            if (t == 0) for (int j = 0; j < 7; ++j) { float v[8]; ld8f(spool + ((size_t)b * 15 + j + 8) * DPOOL + ch, v); st8f(out + O_SPOOL + (((size_t)l * NBS + b) * 15 + j) * DPOOL + ch, v); }
        } else {
            const int ch = (c8 - 64) * 8;
            float x[8], u[8]; ld8f(cb + ch, x);
#pragma unroll
            for (int j = 0; j < 4; ++j) { const int tt = t + j - 3; float v[8], wj[8];
                if (tt >= 0) ld8(Z + (size_t)(m + j - 3) * DMIX + DPOOL + ch, v); else ld8f(srconv + ((size_t)b * 3 + (3 + tt)) * DRNN + ch, v);
                ld8f(cw + (size_t)j * DRNN + ch, wj);
#pragma unroll
                for (int i = 0; i < 8; ++i) x[i] += wj[i] * v[i];
                if (j == 3) {
#pragma unroll
                    for (int i = 0; i < 8; ++i) u[i] = v[i]; } }
            st8(XC + (size_t)m * DRNN + ch, x);
            if (t >= TS - 3) st8f(out + O_SRC + (((size_t)l * NBS + b) * 3 + (t - (TS - 3))) * DRNN + ch, u);
        }
    }
}

__device__ __forceinline__ void attn16_lds(const GAS bf16_t* qrow, LAS unsigned char* lds, GAS bf16_t* orow, int lane) {
    const int q = lane & 15, g = lane >> 4;
    bf16x8 qf[4];
#pragma unroll
    for (int ks = 0; ks < 4; ++ks) qf[ks] = *(const GAS bf16x8*)(qrow + 32 * ks + 8 * g);
    f32x4 s[16];
    const LAS unsigned char* kbase = lds + q * 256;
#pragma unroll
    for (int t = 0; t < 16; ++t) {
        f32x4 a = (f32x4){0.f, 0.f, 0.f, 0.f};
#pragma unroll
        for (int ks = 0; ks < 4; ++ks) a = __builtin_amdgcn_mfma_f32_16x16x32_bf16(*(const LAS bf16x8*)(kbase + t * 4096 + (((g + 4 * ks) ^ q) << 4)), qf[ks], a, 0, 0, 0);
        s[t] = a;
    }
    float mx = -3.0e38f;
#pragma unroll
    for (int t = 0; t < 16; ++t) mx = fmaxf(fmaxf(fmaxf(mx, s[t][0]), fmaxf(s[t][1], s[t][2])), s[t][3]);
    mx = fmaxf(mx, __shfl_xor(mx, 16)); mx = fmaxf(mx, __shfl_xor(mx, 32));
    float sum = 0.f;
#pragma unroll
    for (int t = 0; t < 16; ++t)
#pragma unroll
        for (int r = 0; r < 4; ++r) { const float p = __builtin_amdgcn_exp2f((s[t][r] - mx) * ATT_C); s[t][r] = p; sum += p; }
    sum += __shfl_xor(sum, 16); sum += __shfl_xor(sum, 32);
    const float inv = 1.0f / sum;
    bf16x8 pf[8];
#pragma unroll
    for (int ks = 0; ks < 8; ++ks) { const u32x4 w = pack8(s[2 * ks], s[2 * ks + 1]); pf[ks] = __builtin_bit_cast(bf16x8, w); }
    const LAS unsigned char* vbase = lds + 65536 + q * 512;
#pragma unroll
    for (int nt = 0; nt < 8; ++nt) {
        f32x4 o = (f32x4){0.f, 0.f, 0.f, 0.f};
#pragma unroll
        for (int ks = 0; ks < 8; ++ks) {
            const u32x2 lo = *(const LAS u32x2*)(vbase + nt * 8192 + (((8 * ks + g) ^ (4 * q)) << 3)), hi = *(const LAS u32x2*)(vbase + nt * 8192 + (((8 * ks + 4 + g) ^ (4 * q)) << 3));
            const u32x4 w = (u32x4){lo.x, lo.y, hi.x, hi.y};
            o = __builtin_amdgcn_mfma_f32_16x16x32_bf16(__builtin_bit_cast(bf16x8, w), pf[ks], o, 0, 0, 0);
        }
        *(GAS u32x2*)(orow + 16 * nt + 4 * g) = pack4(o * inv);
    }
}
__device__ __forceinline__ void phase_attention2(const Ctx& C, int l) {
    GAS bf16_t* Z = WSP(bf16_t, WS_Z);
    LAS unsigned char* lds = C.lds + RING_OFF;
    for (int id = C.bid; id < 256; id += C.G) {
        const int x = id & 7, j = id >> 3, pair = x * 4 + (j & 3), qb = j >> 2, b = pair >> 2, h = pair & 3;
        const GAS bf16_t* Kb = WSP(bf16_t, WS_KVB) + ((size_t)l * MEMROWS + b * NMEM) * 512 + h * HDIM;
        const GAS bf16_t* VT = WSP(bf16_t, WS_VTB) + (((size_t)l * NBP + b) * NHEAD + h) * HDIM * NMEM;
#pragma unroll
        for (int jj = 0; jj < 8; ++jj) { const int e = C.tid + NTHR * jj, row = e >> 4, c = e & 15;
            const u32x4 v = *(const GAS u32x4*)(Kb + (size_t)row * 512 + c * 8); *(LAS u32x4*)(lds + row * 256 + ((c ^ (row & 15)) << 4)) = v; }
#pragma unroll
        for (int jj = 0; jj < 8; ++jj) { const int e = C.tid + NTHR * jj, row = e >> 5, c16 = e & 31, c8s = (2 * c16) ^ (4 * (row & 15));
            const u32x4 v = *(const GAS u32x4*)(VT + (size_t)row * NMEM + c16 * 8); *(LAS u32x4*)(lds + 65536 + row * 512 + (c8s << 3)) = v; }
        __syncthreads();
#pragma unroll 1
        for (int kb = 0; kb < 2; ++kb) {
            const int row = b * TP + qb * 256 + C.wave * 32 + kb * 16 + (C.lane & 15);
            GAS bf16_t* qp = Z + (size_t)row * DMIX + (DPOOL + DRNN) + h * HDIM;
            attn16_lds(qp, lds, qp, C.lane);
        }
        __syncthreads();
    }
    LAS float* ML = (LAS float*)(lds);
    LAS float* PL = (LAS float*)(lds + 1024);
    LAS float* OP = (LAS float*)(lds + 16384);
    for (int id = C.bid; id < NBS * NHEAD; id += C.G) {
        const int b = id >> 2, h = id & 3, w = C.wave, q = C.lane & 15, g = C.lane >> 4;
        const GAS float* Kc = C.in[opq(I_CK)] + ((((size_t)l * NBS + b) * NMEM) * NHEAD + h) * HDIM;
        const GAS float* Vc = C.in[opq(I_CV)] + ((((size_t)l * NBS + b) * NMEM) * NHEAD + h) * HDIM;
        const GAS bf16_t* qrow = Z + (size_t)(MPR + b * TS + (q & 7)) * DMIX + (DPOOL + DRNN) + h * HDIM;
        bf16x8 qf[4];
#pragma unroll
        for (int ks = 0; ks < 4; ++ks) qf[ks] = *(const GAS bf16x8*)(qrow + 32 * ks + 8 * g);
        const int hw = C.lane >> 5, d4 = (C.lane & 31) * 4;
        f32x4 vv[16];
#pragma unroll
        for (int kk = 0; kk < 16; ++kk) vv[kk] = *(const GAS f32x4*)(Vc + (size_t)(32 * w + 2 * kk + hw) * (NHEAD * HDIM) + d4);
        f32x4 s[2];
#pragma unroll
        for (int t = 0; t < 2; ++t) {
            f32x4 a = (f32x4){0.f, 0.f, 0.f, 0.f}; const GAS float* kr = Kc + (size_t)(32 * w + 16 * t + q) * (NHEAD * HDIM) + 8 * g;
#pragma unroll
            for (int ks = 0; ks < 4; ++ks) { const u32x4 kw = pack8(*(const GAS f32x4*)(kr + 32 * ks), *(const GAS f32x4*)(kr + 32 * ks + 4));
                a = __builtin_amdgcn_mfma_f32_16x16x32_bf16(__builtin_bit_cast(bf16x8, kw), qf[ks], a, 0, 0, 0); }
            s[t] = a;
        }
        float mx = fmaxf(fmaxf(fmaxf(s[0][0], s[0][1]), fmaxf(s[0][2], s[0][3])), fmaxf(fmaxf(s[1][0], s[1][1]), fmaxf(s[1][2], s[1][3])));
        mx = fmaxf(mx, __shfl_xor(mx, 16)); mx = fmaxf(mx, __shfl_xor(mx, 32));
        float sum = 0.f;
#pragma unroll
        for (int t = 0; t < 2; ++t)
#pragma unroll
            for (int r = 0; r < 4; ++r) { const float p = __builtin_amdgcn_exp2f((s[t][r] - mx) * ATT_C); s[t][r] = p; sum += p; }
        sum += __shfl_xor(sum, 16); sum += __shfl_xor(sum, 32);
        if (g == 0) { ML[(w * 16 + q) * 2 + 0] = mx; ML[(w * 16 + q) * 2 + 1] = sum; }
        if (q < 8) {
#pragma unroll
            for (int t = 0; t < 2; ++t)
#pragma unroll
                for (int r = 0; r < 4; ++r) PL[(w * 32 + 16 * t + 4 * g + r) * 8 + q] = s[t][r];
        }
        LDS_WAIT(); __builtin_amdgcn_wave_barrier();
        f32x4 oacc[8];
#pragma unroll
        for (int qq = 0; qq < 8; ++qq) oacc[qq] = (f32x4){0.f, 0.f, 0.f, 0.f};
#pragma unroll
        for (int kk = 0; kk < 16; ++kk) {
            const LAS f32x4* pp = (const LAS f32x4*)(PL + (w * 32 + 2 * kk + hw) * 8);
            const f32x4 p0 = pp[0], p1 = pp[1];
            oacc[0] += vv[kk] * p0[0]; oacc[1] += vv[kk] * p0[1]; oacc[2] += vv[kk] * p0[2]; oacc[3] += vv[kk] * p0[3];
            oacc[4] += vv[kk] * p1[0]; oacc[5] += vv[kk] * p1[1]; oacc[6] += vv[kk] * p1[2]; oacc[7] += vv[kk] * p1[3];
        }
#pragma unroll
        for (int qq = 0; qq < 8; ++qq) *(LAS f32x4*)(OP + ((w * 2 + hw) * 8 + qq) * 128 + d4) = oacc[qq];
        __syncthreads();
        {
            const int qo = C.tid >> 6, d2 = (C.tid & 63) * 2;
            float mw[8], M = -3.0e38f;
#pragma unroll
            for (int ww = 0; ww < 8; ++ww) { mw[ww] = ML[(ww * 16 + qo) * 2]; M = fmaxf(M, mw[ww]); }
            float L = 0.f, o0 = 0.f, o1 = 0.f;
#pragma unroll
            for (int ww = 0; ww < 8; ++ww) { const float f = __builtin_amdgcn_exp2f((mw[ww] - M) * ATT_C); L += f * ML[(ww * 16 + qo) * 2 + 1];
                const f32x2 oa = *(const LAS f32x2*)(OP + ((ww * 2 + 0) * 8 + qo) * 128 + d2), ob = *(const LAS f32x2*)(OP + ((ww * 2 + 1) * 8 + qo) * 128 + d2);
                o0 += f * (oa[0] + ob[0]); o1 += f * (oa[1] + ob[1]); }
            const float inv = 1.0f / L;
            *(GAS unsigned*)(Z + (size_t)(MPR + b * TS + qo) * DMIX + (DPOOL + DRNN) + h * HDIM + d2) = cvt_pk_bf16(o0 * inv, o1 * inv);
        }
        __syncthreads();
    }
}

#define LDSR (C.lds + RING_OFF)
__device__ __forceinline__ int rot(const Ctx& C, int start) { return (C.bid + C.G - (start % C.G)) % C.G; }

__device__ __forceinline__ void phase_p1(const Ctx& C, int l) {
    { pg8::Gemm g{WSP(bf16_t, WS_HB), WSP(bf16_t, WS_W1) + (size_t)l * 5120 * DM, DM, DM, DM / 64, 0};
      pg8::StaticOrder S; S.init(MT / 256, 20, C.G, C.bid);
      EpiP1 E{WSP(float, WS_SSQ1), WSP(bf16_t, WS_Z), WSP(bf16_t, WS_G), C.in[opq(I_BGATE)] + (size_t)l * 3 * DM};
      pg8::gemm_phase<EpiP1, pg8::StaticOrder, true>(LDSR, C.wave, g, S, E); }
    if (l == 0) {
      pg8::Gemm g{WSP(bf16_t, WS_MEMB), WSP(bf16_t, WS_WKV), DM, DM, DM / 64, 0};
      pg8::StaticOrder S; S.init(MEMROWS / 256, 8, C.G, rot(C, (MT / 256) * 20));
      EpiKV E{WSP(float, WS_SSQM), C.out, WSP(bf16_t, WS_KVB), WSP(bf16_t, WS_VTB)};
      pg8::gemm_phase<EpiKV, pg8::StaticOrder, true>(LDSR, C.wave, g, S, E); }
}
__device__ __forceinline__ void phase_p2b(const Ctx& C, int l) {
    { pg8::Gemm g{WSP(bf16_t, WS_XC), WSP(bf16_t, WS_RW) + (size_t)l * 8 * 256 * 128, DRNN, 128, 2, 128};
      pg8::StaticOrder S; S.init(MT / 256, 8, C.G, C.bid);
      EpiRnn E{C.in[opq(I_RBA)] + (size_t)l * DRNN, C.in[opq(I_RBX)] + (size_t)l * DRNN, WSP(bf16_t, WS_XC), WSP(bf16_t, WS_Z), WSP(bf16_t, WS_PP)};
      pg8::gemm_phase<EpiRnn, pg8::StaticOrder, true>(LDSR, C.wave, g, S, E); }
    { pg8::Gemm g{WSP(bf16_t, WS_DB), WSP(bf16_t, WS_PBD) + (size_t)l * 2 * 256 * 256, DPOOL, 256, 4, 256};
      pg8::StaticOrder S; S.init(MT / 256, 2, C.G, rot(C, (MT / 256) * 8));
      EpiPool E{WSP(bf16_t, WS_Z)};
      pg8::gemm_phase<EpiPool, pg8::StaticOrder, true>(LDSR, C.wave, g, S, E); }
}
__device__ __forceinline__ void phase_p3(const Ctx& C, int l) {
    const GAS bf16_t* Y = WSP(bf16_t, WS_Z); const GAS bf16_t* WB = WSP(bf16_t, WS_WBR) + (size_t)l * DM * DMIX;
    pg8::StaticOrder S; S.init(MT / 256, 4, C.G, C.bid);
    { pg8::Gemm g{Y, WB, DMIX, DMIX, DPOOL / 64, 0};
      EpiMrg<0> E{WSP(bf16_t, WS_G), WSP(float, WS_MRG), WSP(bf16_t, WS_MB)}; pg8::gemm_phase<EpiMrg<0>, pg8::StaticOrder, true>(LDSR, C.wave, g, S, E); }
    { pg8::Gemm g{Y + DPOOL, WB + DPOOL, DMIX, DMIX, DRNN / 64, 0};
      EpiMrg<1> E{WSP(bf16_t, WS_G), WSP(float, WS_MRG), WSP(bf16_t, WS_MB)}; pg8::gemm_phase<EpiMrg<1>, pg8::StaticOrder, true>(LDSR, C.wave, g, S, E); }
    { pg8::Gemm g{Y + DPOOL + DRNN, WB + DPOOL + DRNN, DMIX, DMIX, DQ / 64, 0};
      EpiMrg<2> E{WSP(bf16_t, WS_G), WSP(float, WS_MRG), WSP(bf16_t, WS_MB)}; pg8::gemm_phase<EpiMrg<2>, pg8::StaticOrder, true>(LDSR, C.wave, g, S, E); }
}
__device__ __forceinline__ void phase_p4(const Ctx& C, int l) {
    pg8::Gemm g{WSP(bf16_t, WS_MB), WSP(bf16_t, WS_WOUT) + (size_t)l * DM * DM, DM, DM, DM / 64, 0};
    pg8::StaticOrder S; S.init(MT / 256, 4, C.G, C.bid);
    const GAS float* bP = (l == 0) ? C.in[opq(I_XP)] : WSP(float, WS_H); const GAS float* bS = (l == 0) ? C.in[opq(I_XS)] : WSP(float, WS_H) + (size_t)MPR * DM;
    EpiRes E{bP, bS, WSP(float, WS_H), WSP(bf16_t, WS_HB), WSP(float, WS_SSQ2)};
    pg8::gemm_phase<EpiRes, pg8::StaticOrder, true>(LDSR, C.wave, g, S, E);
}
__device__ __forceinline__ void phase_p5(const Ctx& C, int l) {
    pg8::Gemm g{WSP(bf16_t, WS_HB), WSP(bf16_t, WS_WUP) + (size_t)l * 2 * DFF * DM, DM, DM, DM / 64, 0};
    pg8::StaticOrder S; S.init(MT / 256, 24, C.G, C.bid);
    EpiUp E{WSP(float, WS_SSQ2), WSP(bf16_t, WS_GV)};
    pg8::gemm_phase<EpiUp, pg8::StaticOrder, true>(LDSR, C.wave, g, S, E);
}
__device__ __forceinline__ void phase_p7(const Ctx& C, int l) {
    pg8::Gemm g{WSP(bf16_t, WS_ACT), WSP(bf16_t, WS_WDOWN) + (size_t)l * DM * DFF, DFF, DFF, DFF / 64, 0};
    pg8::StaticOrder S; S.init(MT / 256, 4, C.G, C.bid);
    EpiRes E{WSP(float, WS_H), WSP(float, WS_H) + (size_t)MPR * DM, WSP(float, WS_H), WSP(bf16_t, WS_HB), WSP(float, WS_SSQ1)};
    pg8::gemm_phase<EpiRes, pg8::StaticOrder, true>(LDSR, C.wave, g, S, E);
}

constexpr int NPHASE = 22;
#ifndef MK_ONE_LAUNCH
#define MK_ONE_LAUNCH 1
#endif

__global__ void __launch_bounds__(NTHR, 2) fwd_kernel(Args args) {
    extern __shared__ __attribute__((aligned(16))) unsigned char lds_raw[];
    Ctx C;
    const int wave0 = __builtin_amdgcn_readfirstlane((int)threadIdx.x >> 6);
    C.lds = (LAS unsigned char*)lds_raw; C.tid = threadIdx.x; C.lane = C.tid & 63; C.wave = wave0;
    C.G = gridDim.x; C.bid = blockIdx.x; C.in = nullptr; C.out = args.out; C.ws = args.ws;
    volatile LAS unsigned* MISC = (volatile LAS unsigned*)(C.lds + MISC_OFF);
    for (int u = C.tid; u < (LDS_BYTES - LDSCTL_OFF) / 4; u += NTHR) ((LAS unsigned*)(C.lds + LDSCTL_OFF))[u] = 0u;
    __syncthreads();
    const int lo = args.ph_lo, hi = args.ph_hi;
    XcdBarrier bar; bar.bar = (unsigned*)(C.ws + WS_CTL) + CW_BAR; bar.x = 0; bar.st = nullptr;
    if (hi - lo > 1) bar = xcd_barrier_post((unsigned*)(C.ws + WS_CTL) + CW_BAR, MISC + 8);
#define PH_SETUP() do { int wave_ = wave0; asm volatile("" : "+s"(wave_)); const int lane_ = pg8::fresh_lane(); \
        C.in = (const GAS float* const CAS*)args.in; C.tid = wave_ * 64 + lane_; C.lane = lane_; C.wave = wave_; C.bid = blockIdx.x; C.ws = args.ws; C.out = args.out; } while (0)
#define PH_BAR(k) do { if ((k) + 1 < hi) { int w_ = wave0; asm volatile("" : "+s"(w_)); xcd_barrier(bar, w_ == 0 && pg8::fresh_lane() == 0); } } while (0)
#ifndef PROBE_MASK
#define PROBE_MASK 0u
#endif
#ifndef PROBE_SUB
#define PROBE_SUB 0
#endif
#ifndef PROBE_MULT
#define PROBE_MULT 4
#endif
    unsigned long long probe_acc = 0ull;
#define PH(k, body) do { if (lo <= (k) && (k) < hi) { unsigned long long t0_ = 0ull; if (PROBE_MASK != 0u) t0_ = __builtin_amdgcn_s_memrealtime(); PH_SETUP(); body; PH_BAR(k); \
        if ((PROBE_MASK >> (k)) & 1u) probe_acc += __builtin_amdgcn_s_memrealtime() - t0_; } } while (0)
#ifndef PHM
#define PHM 0xFFFF
#endif
    PH(0, if (PHM & 1) phase_prologue(C));
#define LAYER(l) do { const int pb = 1 + 10 * (l); \
        PH(pb + 0, if (PHM & 4) phase_p1(C, l)); \
        PH(pb + 1, if (PHM & 8) { if (OPT_ATTN) phase_attention2(C, l); else phase_attention(C, l); } if (PROBE_SUB == 1) probe_acc += __builtin_amdgcn_s_memrealtime() - t0_; if (PHM & 16) { if (OPT_MIX) phase_mix_elem2(C, l); else phase_mix_elem(C, l); }); \
        PH(pb + 2, if (PHM & 32) phase_p2b(C, l)); \
        PH(pb + 3, if (PHM & 64) phase_scan_a(C, l)); \
        PH(pb + 4, if (PHM & 128) phase_scan_b(C, l)); \
        PH(pb + 5, if (PHM & 256) phase_p3(C, l)); \
        PH(pb + 6, if (PHM & 512) phase_p4(C, l)); \
        PH(pb + 7, if (PHM & 1024) phase_p5(C, l)); \
        PH(pb + 8, if (PHM & 2048) { if (OPT_FFN) phase_ffn_elem2(C, l); else phase_ffn_elem(C, l); }); \
        PH(pb + 9, if (PHM & 4096) phase_p7(C, l)); } while (0)
    LAYER(0);
    LAYER(1);
    PH(NPHASE - 1, if (PHM & 2) phase_final(C));
    if (PROBE_MASK != 0u && blockIdx.x == 0) {
        const unsigned long long t1 = __builtin_amdgcn_s_memrealtime();
        while (__builtin_amdgcn_s_memrealtime() - t1 < (unsigned long long)PROBE_MULT * probe_acc) __builtin_amdgcn_s_sleep(32);
    }
}

extern "C" void kernel_launch(void* const* d_in, const int* in_sizes, int n_in, void* d_out, int out_size, void* d_ws, size_t ws_size, hipStream_t stream) {
    static int grid = 0;
    if (grid == 0) {
        if (n_in != N_IN || out_size != (int)O_END || ws_size < WS_END) {
            fprintf(stderr, "kernel_launch: built for %d inputs, %zu outputs, >= %zu bytes of workspace; got n_in %d, out %d, ws %zu; nothing launched\n", (int)N_IN, (size_t)O_END, (size_t)WS_END, n_in, out_size, ws_size); grid = -1; return; }
        int dev = 0, cus = 0, per_cu = 0;
        if (hipGetDevice(&dev) != hipSuccess || hipDeviceGetAttribute(&cus, hipDeviceAttributeMultiprocessorCount, dev) != hipSuccess) { fprintf(stderr, "kernel_launch: device query failed\n"); grid = -1; return; }
        if (hipFuncSetAttribute((const void*)fwd_kernel, hipFuncAttributeMaxDynamicSharedMemorySize, LDS_BYTES) != hipSuccess) { fprintf(stderr, "kernel_launch: hipFuncSetAttribute failed\n"); grid = -1; return; }
        if (hipOccupancyMaxActiveBlocksPerMultiprocessor(&per_cu, (const void*)fwd_kernel, NTHR, LDS_BYTES) != hipSuccess || per_cu < 1) { fprintf(stderr, "kernel_launch: occupancy query says %d blocks per CU\n", per_cu); per_cu = 1; }
        (void)hipGetLastError();
        grid = cus;
        if (grid > 256) grid = 256;
    }
    if (grid < 0) return;
    (void)hipMemsetAsync((char*)d_ws + WS_CTL, 0, CTL_ZERO_BYTES, stream);
    Args a{};
    for (int i = 0; i < N_IN; ++i) a.in[i] = (const GAS float*)d_in[i];
    a.out = (GAS float*)d_out; a.ws = (GAS unsigned char*)d_ws;
#if MK_ONE_LAUNCH
    a.ph_lo = 0; a.ph_hi = NPHASE;
    void* kargs[] = {&a};
    hipError_t e = hipLaunchCooperativeKernel((const void*)fwd_kernel, dim3(grid), dim3(NTHR), kargs, LDS_BYTES, stream);
    if (e != hipSuccess) fprintf(stderr, "kernel_launch: cooperative launch failed: %s (grid %d)\n", hipGetErrorString(e), grid);
#else
    for (int ph = 0; ph < NPHASE; ++ph) { a.ph_lo = ph; a.ph_hi = ph + 1; hipLaunchKernelGGL(fwd_kernel, dim3(grid), dim3(NTHR), LDS_BYTES, stream, a); }
#endif
}
```

```cpp
#include <hip/hip_runtime.h>
#include <cstdio>
#include <cstdint>

#define GAS __attribute__((address_space(1)))
#define LAS __attribute__((address_space(3)))
#define CAS __attribute__((address_space(4)))
typedef unsigned short bf16_t;
typedef short bf16x8 __attribute__((ext_vector_type(8)));
typedef float f32x4 __attribute__((ext_vector_type(4)));
typedef float f32x2 __attribute__((ext_vector_type(2)));
typedef unsigned u32x4 __attribute__((ext_vector_type(4)));
typedef unsigned u32x2 __attribute__((ext_vector_type(2)));
#define RLX_AGENT __ATOMIC_RELAXED, __HIP_MEMORY_SCOPE_AGENT
#define LDS_WAIT() asm volatile("s_waitcnt lgkmcnt(0)" ::: "memory")
#define VM_WAIT() asm volatile("s_waitcnt vmcnt(0)" ::: "memory")

namespace pg8 {
constexpr int BM = 256, BK = 64, HALF = 128, HTB = HALF * BK * 2  , STAGE_BYTES = 8 * HTB, NXCD = 8, WGM = 8;

__host__ __device__ __forceinline__ int lds_byte(int r, int c) { const int st = (r >> 4) * 2 + (c >> 5), rr = r & 15, cc = c & 31, ob = rr * 64 + cc * 2; return st * 1024 + (ob ^ (((ob >> 9) & 1) << 5)); }
__host__ __device__ __forceinline__ void stage_rc(int b, int& R, int& C) { const int st = b / 1024, sb = b % 1024, swz = sb ^ (((sb >> 9) & 1) << 5); R = (st >> 1) * 16 + swz / 64; C = (st & 1) * 32 + (swz % 64) / 2; }
__host__ __device__ __forceinline__ int perm32(int rho) { const int n = rho >> 4, i = rho & 15; return 8 * (i >> 2) + 4 * n + (i & 3); }

struct Unit { int pm, pn; };
struct Gemm { const GAS bf16_t* A; const GAS bf16_t* Bt; int lda, ldb, nt, a_pn; };

struct StaticOrder {
    int nM, nN, nwg, G, c;
    __host__ __device__ void init(int nM_, int nN_, int G_, int c_) { nM = nM_; nN = nN_; nwg = nM * nN; G = G_; c = c_; }
    __host__ __device__ bool next(int i, Unit& u) const {
        const long L = (long)i * G + c; if (L >= nwg) return false;
        int wgid = (int)L; { const int q = nwg / NXCD, r = nwg % NXCD, xcd = wgid % NXCD, off = wgid / NXCD; wgid = (xcd < r ? xcd * (q + 1) : r * (q + 1) + (xcd - r) * q) + off; }
        const int nig = WGM * nN, gid = wgid / nig, fm = gid * WGM, gsz = (nM - fm) < WGM ? (nM - fm) : WGM;
        u.pm = fm + ((wgid % nig) % gsz); u.pn = (wgid % nig) / gsz; return true;
    }
};

__device__ __forceinline__ int fresh_lane() { int l; asm volatile("v_mbcnt_lo_u32_b32 %0, -1, 0\n\tv_mbcnt_hi_u32_b32 %0, -1, %0" : "=v"(l)); return l; }
__device__ __forceinline__ unsigned cvt_pk_bf16(float lo, float hi) { unsigned r; asm volatile("v_cvt_pk_bf16_f32 %0, %1, %2" : "=v"(r) : "v"(lo), "v"(hi)); return r; }

template <class Epi, class Sched, bool ALIGN_EPI = false>
__device__ __forceinline__ void gemm_phase(LAS unsigned char* lds, const int wid, const Gemm g, const Sched& S, const Epi& E) {
    const int lane = fresh_lane(), tid = wid * 64 + lane, wr = wid >> 2, wc = wid & 3, fr = lane & 15, fq = lane >> 4;
    const int nt = g.nt;
    unsigned voffA[2], voffB[2];
#pragma unroll
    for (int i = 0; i < 2; ++i) { int R, C; stage_rc(tid * 16 + i * 8192, R, C); const int Rb = Epi::PERM ? ((R & ~31) + perm32(R & 31)) : R;
        voffA[i] = (unsigned)(R * g.lda + C) * 2u; voffB[i] = (unsigned)(Rb * g.ldb + C) * 2u; }
    const size_t kstep = (size_t)(BK * 2);
    const size_t hstepA = (size_t)HALF * g.lda * 2, hstepB = (size_t)HALF * g.ldb * 2;
    const size_t tstepA = 2 * hstepA, tstepB = 2 * hstepB;
    const size_t apn = (size_t)g.a_pn * 2;
    const unsigned ldsw = (unsigned)wid * 1024u;
    const int aoff = lds_byte(wr * 64 + fr, fq * 8), boff = lds_byte(wc * 32 + fr, fq * 8);
#define PG8_SA(b, h) (((b) * 2 + (h)) * HTB)
#define PG8_SB(b, h) ((4 + (b) * 2 + (h)) * HTB)
#define PG8_STAGE(bufoff, gbase, voff) do { const GAS char* gb_ = (gbase); asm volatile("" : "+s"(gb_));   \
        _Pragma("unroll") for (int _i = 0; _i < 2; ++_i) \
        __builtin_amdgcn_global_load_lds((const GAS unsigned*)(gb_ + (voff)[_i]), (LAS unsigned*)(lds + (bufoff) + ldsw + _i * 8192), 16, 0, 0); } while (0)
#define PG8_LDA(dst, b, h) do { _Pragma("unroll") for (int m = 0; m < 4; ++m) _Pragma("unroll") for (int k = 0; k < 2; ++k) dst[m][k] = *(const LAS bf16x8*)(lds + PG8_SA(b, h) + aoff + m * 2048 + k * 1024); } while (0)
#define PG8_LDB(dst, b, h) do { _Pragma("unroll") for (int n = 0; n < 2; ++n) _Pragma("unroll") for (int k = 0; k < 2; ++k) dst[n][k] = *(const LAS bf16x8*)(lds + PG8_SB(b, h) + boff + n * 2048 + k * 1024); } while (0)
#define PG8_MMA(ai, bj, At, Bt) do { __builtin_amdgcn_s_setprio(1); _Pragma("unroll") for (int m = 0; m < 4; ++m) _Pragma("unroll") for (int n = 0; n < 2; ++n) _Pragma("unroll") for (int k = 0; k < 2; ++k) \
        acc[ai][bj][m][n] = __builtin_amdgcn_mfma_f32_16x16x32_bf16(Bt[n][k], At[m][k], acc[ai][bj][m][n], 0, 0, 0); __builtin_amdgcn_s_setprio(0); } while (0)
#define PG8_WAIT_V(n) asm volatile("s_waitcnt vmcnt(" #n ")" ::: "memory")
#define PG8_WAIT_L(n) asm volatile("s_waitcnt lgkmcnt(" #n ")" ::: "memory")
#define PG8_BAR __builtin_amdgcn_s_barrier()
#define PG8_SCHED __builtin_amdgcn_sched_barrier(0)
    Unit cur, nxt; int ui = 0;
    if (!S.next(0, cur)) return;
    f32x4 acc[2][2][4][2];
#pragma unroll
    for (int a = 0; a < 2; ++a)
#pragma unroll
        for (int b = 0; b < 2; ++b)
#pragma unroll
            for (int m = 0; m < 4; ++m)
#pragma unroll
                for (int n = 0; n < 2; ++n) acc[a][b][m][n] = (f32x4){0.f, 0.f, 0.f, 0.f};
    bf16x8 At[4][2], B0[2][2], B1[2][2];
    const GAS char* cA = (const GAS char*)g.A + (size_t)cur.pm * tstepA + (size_t)cur.pn * apn; const GAS char* cB = (const GAS char*)g.Bt + (size_t)cur.pn * tstepB;
    PG8_STAGE(PG8_SB(0, 0), cB, voffB); PG8_STAGE(PG8_SB(0, 1), cB + hstepB, voffB); PG8_STAGE(PG8_SA(0, 0), cA, voffA); PG8_STAGE(PG8_SA(0, 1), cA + hstepA, voffA);
    if (wr == 1) PG8_BAR;
    PG8_WAIT_V(2); PG8_BAR;
    PG8_STAGE(PG8_SB(1, 0), cB + kstep, voffB); PG8_STAGE(PG8_SA(1, 0), cA + kstep, voffA); PG8_STAGE(PG8_SB(1, 1), cB + hstepB + kstep, voffB);
    PG8_WAIT_V(6); PG8_BAR;
    for (;;) {
        const bool has_next = S.next(ui + 1, nxt);
        const GAS char* nA = has_next ? (const GAS char*)g.A + (size_t)nxt.pm * tstepA + (size_t)nxt.pn * apn : cA; const GAS char* nB = has_next ? (const GAS char*)g.Bt + (size_t)nxt.pn * tstepB : cB;
        for (int t = 0; t < nt; t += 2) {
            const bool last = (t == nt - 2);
            const GAS char* a1 = cA + (size_t)(t + 1) * kstep;
            const GAS char* a2 = last ? nA : cA + (size_t)(t + 2) * kstep; const GAS char* b2 = last ? nB : cB + (size_t)(t + 2) * kstep;
            const GAS char* a3 = a2 + kstep; const GAS char* b3 = b2 + kstep;
            PG8_LDB(B0, 0, 0); PG8_LDB(B1, 0, 1); PG8_SCHED; PG8_LDA(At, 0, 0); PG8_STAGE(PG8_SA(1, 1), a1 + hstepA, voffA);
            PG8_WAIT_V(8); PG8_WAIT_L(0); PG8_BAR; PG8_MMA(0, 0, At, B0); PG8_MMA(0, 1, At, B1); PG8_BAR; PG8_SCHED;
            PG8_LDA(At, 0, 1); PG8_STAGE(PG8_SB(0, 0), b2, voffB); PG8_STAGE(PG8_SB(0, 1), b2 + hstepB, voffB); PG8_STAGE(PG8_SA(0, 0), a2, voffA);
            PG8_WAIT_V(8); PG8_WAIT_L(0); PG8_BAR; PG8_MMA(1, 0, At, B0); PG8_MMA(1, 1, At, B1); PG8_BAR; PG8_SCHED;
            PG8_LDB(B0, 1, 0); PG8_LDB(B1, 1, 1); PG8_SCHED; PG8_LDA(At, 1, 0); PG8_STAGE(PG8_SA(0, 1), a2 + hstepA, voffA);
            PG8_WAIT_V(8); PG8_WAIT_L(0); PG8_BAR; PG8_MMA(0, 0, At, B0); PG8_MMA(0, 1, At, B1); PG8_BAR; PG8_SCHED;
            PG8_LDA(At, 1, 1); PG8_STAGE(PG8_SB(1, 0), b3, voffB); PG8_STAGE(PG8_SB(1, 1), b3 + hstepB, voffB); PG8_STAGE(PG8_SA(1, 0), a3, voffA);
            PG8_WAIT_V(8); PG8_WAIT_L(0); PG8_BAR; PG8_MMA(1, 0, At, B0); PG8_MMA(1, 1, At, B1); PG8_BAR; PG8_SCHED;
            if constexpr (Epi::HAS_MID) {
                if (t + 2 == Epi::SEAM1 || t + 2 == Epi::SEAM2) { const int l2 = fresh_lane(); E.mid(acc, cur, (t + 2 == Epi::SEAM1) ? 0 : 1, wr, wc, l2 & 15, l2 >> 4); }
            }
        }
        if constexpr (ALIGN_EPI) { if (wr == 0) PG8_BAR; }
        { const int l2 = fresh_lane(); E(acc, cur, wr, wc, l2 & 15, l2 >> 4); }
        if (!has_next) break;
#pragma unroll
        for (int a = 0; a < 2; ++a)
#pragma unroll
            for (int b = 0; b < 2; ++b)
#pragma unroll
                for (int m = 0; m < 4; ++m)
#pragma unroll
                    for (int n = 0; n < 2; ++n) acc[a][b][m][n] = (f32x4){0.f, 0.f, 0.f, 0.f};
        cur = nxt; cA = nA; cB = nB; ++ui;
        if constexpr (ALIGN_EPI) { if (wr == 1) PG8_BAR; }
    }
    PG8_WAIT_V(0);
    if constexpr (!ALIGN_EPI) { if (wr == 0) PG8_BAR; }
    PG8_BAR;
#undef PG8_SA
#undef PG8_SB
#undef PG8_STAGE
#undef PG8_LDA
#undef PG8_LDB
#undef PG8_MMA
#undef PG8_WAIT_V
#undef PG8_WAIT_L
#undef PG8_BAR
#undef PG8_SCHED
}
}
#define XB_TMO      128
#define XB_XCNT(j)  (256  + 64 * (j))
#define XB_XSUB(j)  (1280 + 64 * (j))
#define XB_XGEN(j)  (2304 + 64 * (j))
#define XB_TOP      3328
#define XB_TOPGEN   3392
#define XCD_BAR_WORDS 3456
#define XB_SPIN_CAP (1u << 18)

__device__ __forceinline__ unsigned xb_ld(unsigned* p)              { return __hip_atomic_load(p, __ATOMIC_RELAXED, __HIP_MEMORY_SCOPE_AGENT); }
__device__ __forceinline__ unsigned xb_add(unsigned* p, unsigned v) { return __hip_atomic_fetch_add(p, v, __ATOMIC_RELAXED, __HIP_MEMORY_SCOPE_AGENT); }
__device__ __forceinline__ unsigned xb_xcc_id() { return (unsigned)__builtin_amdgcn_s_getreg((3 << 11) | 20) & 0xFu; }
#define XB_SPIN(cond, bar) do { unsigned _sp = 0; while (cond) { __builtin_amdgcn_s_sleep(1); \
    if ((++_sp & 255u) == 0u) { if (xb_ld(&(bar)[XB_TMO])) break; if (_sp > XB_SPIN_CAP) { atomicAdd(&(bar)[XB_TMO], 1u); break; } } } } while (0)

struct XcdBarrier {
    unsigned* bar; unsigned x;
    volatile LAS unsigned* st;
};

__device__ __forceinline__ XcdBarrier xcd_barrier_post(unsigned* bar, volatile LAS unsigned* st) {
    XcdBarrier b; b.bar = bar; b.x = xb_xcc_id(); b.st = st;
    if (threadIdx.x == 0) (void)xb_add(&bar[XB_XCNT(b.x)], 1u);
    return b;
}
__device__ __forceinline__ void xcd_barrier_complete(unsigned* bar, unsigned x, unsigned& nloc, unsigned& nx) {
    const unsigned G = gridDim.x * gridDim.y * gridDim.z;
    unsigned sum, cnt, mine, sp = 0u;
    for (;;) {
        sum = 0u; cnt = 0u; mine = 0u;
#pragma unroll
        for (unsigned j = 0; j < 16; ++j) { const unsigned c = xb_ld(&bar[XB_XCNT(j)]); sum += c; cnt += (c > 0u) ? 1u : 0u; mine = (j == x) ? c : mine; }
        if (sum == G) break;
        __builtin_amdgcn_s_sleep(1);
        if ((++sp & 255u) == 0u) { if (xb_ld(&bar[XB_TMO])) break; if (sp > XB_SPIN_CAP) { atomicAdd(&bar[XB_TMO], 1u); break; } }
    }
    nloc = mine > 0u ? mine : 1u; nx = cnt > 0u ? cnt : 1u;
}

__device__ __forceinline__ void xcd_barrier(const XcdBarrier& b, const bool t0) {
    asm volatile("s_waitcnt vmcnt(0)" ::: "memory");
    __syncthreads();
    if (t0) {
        unsigned* bar = b.bar;
        __builtin_amdgcn_s_waitcnt(0);
        unsigned nloc = b.st[0], nx = b.st[1];
        if (nloc == 0u) { xcd_barrier_complete(bar, b.x, nloc, nx); b.st[0] = nloc; b.st[1] = nx; }
        const unsigned old = xb_add(&bar[XB_XSUB(b.x)], 1u);
        const unsigned gen = old / nloc;
        if (old + 1u == (gen + 1u) * nloc) {
            __builtin_amdgcn_fence(__ATOMIC_RELEASE, "agent");
            asm volatile("s_waitcnt vmcnt(0)" ::: "memory");
            const unsigned og = xb_add(&bar[XB_TOP], 1u);
            const unsigned tg = og / nx;
            if (og + 1u == (tg + 1u) * nx) xb_add(&bar[XB_TOPGEN], 1u);
            else XB_SPIN(xb_ld(&bar[XB_TOPGEN]) == tg, bar);
            __builtin_amdgcn_fence(__ATOMIC_ACQUIRE, "agent");
            xb_add(&bar[XB_XGEN(b.x)], 1u);
            asm volatile("s_waitcnt vmcnt(0)" ::: "memory");
        } else {
            XB_SPIN(xb_ld(&bar[XB_XGEN(b.x)]) == gen, bar);
            __builtin_amdgcn_fence(__ATOMIC_ACQUIRE, "agent");
            asm volatile("s_waitcnt vmcnt(0)" ::: "memory");
        }
    }
    __syncthreads();
}

constexpr int DM = 1024, MPR = 16384, MSA = 1024, MT = MPR + MSA;
constexpr int NBP = 8, TP = 2048, NBS = 128, TS = 8, NL = 2;
constexpr int DPOOL = 512, DRNN = 1024, DQ = 512, DMIX = 2048, DFF = 3072, NMEM = 256, NHEAD = 4, HDIM = 128;
constexpr int MEMROWS = NBP * NMEM;
constexpr float EPSN = 1e-6f;
constexpr size_t O_Y = 0, O_PPOOL = 17825792, O_PRC = 17948672, O_PRH = 17997824, O_PFC = 18014208, O_PMK = 18112512, O_PMV = 20209664,
                 O_SPOOL = 22306816, O_SRC = 24272896, O_SRH = 25059328, O_SFC = 25321472, O_END = 26894336;
enum { I_XP = 0, I_XS, I_MEM, I_CK, I_CV, I_SPOOL, I_SRC, I_SRH, I_SFC, I_GMIX, I_WIN, I_WGATE, I_BGATE, I_POOLW, I_POOLS, I_RCW, I_RCB, I_RWA, I_RBA, I_RWX, I_RBX,
       I_LAM, I_GMEM, I_WK, I_WV, I_WBP, I_WBR, I_WBA, I_WOUT, I_GFFN, I_WUP, I_FCW, I_FCB, I_WDOWN, I_GFIN, N_IN };

constexpr size_t MiB = 1u << 20;
constexpr size_t WS_CTL = 0, CTL_ZERO_BYTES = 64 * 1024;
constexpr size_t WS_W1 = 1 * MiB;
constexpr size_t WS_WKV = 21 * MiB;
constexpr size_t WS_WBR = 25 * MiB;
constexpr size_t WS_WOUT = 33 * MiB;
constexpr size_t WS_WUP = 37 * MiB;
constexpr size_t WS_WDOWN = 61 * MiB;
constexpr size_t WS_PBD = 73 * MiB;
constexpr size_t WS_RW = 74 * MiB;
constexpr size_t WS_MEMB = 75 * MiB;
constexpr size_t WS_KVB = 79 * MiB;
constexpr size_t WS_VTB = 83 * MiB;
constexpr size_t WS_SSQM = 87 * MiB;
constexpr size_t WS_SSQ1 = 88 * MiB;
constexpr size_t WS_SSQ2 = 90 * MiB;
constexpr size_t WS_AGG = 92 * MiB;
constexpr size_t WS_H = 96 * MiB;
constexpr size_t WS_HB = 164 * MiB;
constexpr size_t WS_R = 198 * MiB;
constexpr size_t WS_Z = WS_R;
constexpr size_t WS_G = WS_R + 68 * MiB;
constexpr size_t WS_DB = WS_R + 170 * MiB;
constexpr size_t WS_XC = WS_R + 187 * MiB;
constexpr size_t WS_PP = WS_R + 221 * MiB;
constexpr size_t WS_MRG = WS_XC;
constexpr size_t WS_MB = WS_R + 255 * MiB;
constexpr size_t WS_GV = WS_R;
constexpr size_t WS_ACT = WS_R + 204 * MiB;
constexpr size_t WS_END = WS_R + 306 * MiB;
static_assert((size_t)MT * 1024 * 2 == 34 * MiB, "row-buffer size");
constexpr int CW_BAR = 4096;

constexpr int RING_OFF = 0, RING_BYTES = 131072;
constexpr int LDSCTL_OFF = RING_BYTES, MISC_OFF = LDSCTL_OFF + 320;
constexpr int LDS_BYTES = 147456;
constexpr int NWAVES = 8, NTHR = 512;

using pg8::cvt_pk_bf16;
__device__ __forceinline__ float bf_lo(unsigned w) { return __uint_as_float(w << 16); }
__device__ __forceinline__ float bf_hi(unsigned w) { return __uint_as_float(w & 0xffff0000u); }
__device__ __forceinline__ float bf1(bf16_t b) { return __uint_as_float((unsigned)b << 16); }
__device__ __forceinline__ f32x4 unpack4(u32x2 w) { return (f32x4){bf_lo(w.x), bf_hi(w.x), bf_lo(w.y), bf_hi(w.y)}; }
__device__ __forceinline__ u32x2 pack4(f32x4 v) { u32x2 w; w.x = cvt_pk_bf16(v[0], v[1]); w.y = cvt_pk_bf16(v[2], v[3]); return w; }
__device__ __forceinline__ u32x4 pack8(f32x4 a, f32x4 b) { u32x4 w; w.x = cvt_pk_bf16(a[0], a[1]); w.y = cvt_pk_bf16(a[2], a[3]); w.z = cvt_pk_bf16(b[0], b[1]); w.w = cvt_pk_bf16(b[2], b[3]); return w; }
__device__ __forceinline__ float sigmoidf_(float x) { return __builtin_amdgcn_rcpf(1.0f + __expf(-x)); }
__device__ __forceinline__ f32x4 sigmoid4(f32x4 v) { return (f32x4){sigmoidf_(v[0]), sigmoidf_(v[1]), sigmoidf_(v[2]), sigmoidf_(v[3])}; }
__device__ __forceinline__ float wave_sum(float v) {
#pragma unroll
    for (int o = 1; o < 64; o <<= 1) v += __shfl_xor(v, o);
    return v;
}
__device__ __forceinline__ float row_rs(const GAS float* ssq, int row, int fq) {
    const f32x4 p = *(const GAS f32x4*)(ssq + (size_t)row * 16 + 4 * fq);
    float s = (p[0] + p[1]) + (p[2] + p[3]);
    s += __shfl_xor(s, 16); s += __shfl_xor(s, 32);
    return rsqrtf(s * (1.0f / 1024.0f) + EPSN);
}

using pg8::Unit;
typedef f32x4 AccT[2][2][4][2];

struct EpiP1 {
    static constexpr bool PERM = true, HAS_MID = false;
    const GAS float* ssq; GAS bf16_t* Z; GAS bf16_t* G; const GAS float* bgate;
    __device__ __forceinline__ void operator()(AccT& acc, const Unit& u, int wr, int wc, int fr, int fq) const {
        const int row0 = u.pm * 256 + wr * 64 + fr;
        const bool isz = u.pn < 8;
        const int col0 = (isz ? u.pn : u.pn - 8) * 256 + wc * 32 + 8 * fq;
        GAS bf16_t* base = isz ? Z : G; const int ld = isz ? DMIX : 3 * DM;
        f32x4 bv[2][2];
#pragma unroll
        for (int bj = 0; bj < 2; ++bj)
#pragma unroll
            for (int n = 0; n < 2; ++n) bv[bj][n] = isz ? (f32x4){0.f, 0.f, 0.f, 0.f} : *(const GAS f32x4*)(bgate + col0 + bj * 128 + 4 * n);
#pragma unroll
        for (int ai = 0; ai < 2; ++ai)
#pragma unroll
            for (int m = 0; m < 4; ++m) {
                int row = row0 + ai * 128 + m * 16; asm volatile("" : "+v"(row)); const float rs = row_rs(ssq, row, fq);
                GAS bf16_t* rowp = base + (size_t)row * ld + col0;
#pragma unroll
                for (int bj = 0; bj < 2; ++bj) {
                    f32x4 v0 = acc[ai][bj][m][0] * rs + bv[bj][0], v1 = acc[ai][bj][m][1] * rs + bv[bj][1];
                    if (!isz) { v0 = sigmoid4(v0); v1 = sigmoid4(v1); }
                    *(GAS u32x4*)(rowp + bj * 128) = pack8(v0, v1);
                }
            }
    }
};
struct EpiKV {
    static constexpr bool PERM = false, HAS_MID = false;
    const GAS float* ssq; GAS float* out; GAS bf16_t* KVB; GAS bf16_t* VTB;
    __device__ __forceinline__ void operator()(AccT& acc, const Unit& u, int wr, int wc, int fr, int fq) const {
        const int t = u.pn >> 1, l = t >> 1; const bool isv = (t & 1) != 0;
        const int row0 = u.pm * 256 + wr * 64 + fr, colb = (u.pn & 1) * 256 + wc * 32 + 4 * fq;
        GAS float* ob = out + (isv ? O_PMV : O_PMK) + (size_t)l * MEMROWS * 512;
#pragma unroll
        for (int ai = 0; ai < 2; ++ai)
#pragma unroll
            for (int m = 0; m < 4; ++m) {
                int row = row0 + ai * 128 + m * 16; asm volatile("" : "+v"(row)); const float rs = row_rs(ssq, row, fq);
#pragma unroll
                for (int bj = 0; bj < 2; ++bj)
#pragma unroll
                    for (int n = 0; n < 2; ++n) {
                        const int c = colb + bj * 128 + 16 * n; const f32x4 v = acc[ai][bj][m][n] * rs;
                        *(GAS f32x4*)(ob + (size_t)row * 512 + c) = v;
                        if (!isv) *(GAS u32x2*)(KVB + ((size_t)l * MEMROWS + row) * 512 + c) = pack4(v);
                        else { const int b = row >> 8, key = row & 255, h = c >> 7, d = c & 127;
                            GAS bf16_t* p = VTB + ((((size_t)l * NBP + b) * NHEAD + h) * HDIM + d) * NMEM + key; const u32x2 w = pack4(v);
                            p[0] = (bf16_t)(w.x & 0xffffu); p[NMEM] = (bf16_t)(w.x >> 16); p[2 * NMEM] = (bf16_t)(w.y & 0xffffu); p[3 * NMEM] = (bf16_t)(w.y >> 16); }
                    }
            }
    }
};
struct EpiPool {
    static constexpr bool PERM = true, HAS_MID = false;
    GAS bf16_t* Z;
    __device__ __forceinline__ void operator()(AccT& acc, const Unit& u, int wr, int wc, int fr, int fq) const {
        const int row0 = u.pm * 256 + wr * 64 + fr, col0 = u.pn * 256 + wc * 32 + 8 * fq;
#pragma unroll
        for (int ai = 0; ai < 2; ++ai)
#pragma unroll
            for (int m = 0; m < 4; ++m) { int row = row0 + ai * 128 + m * 16; asm volatile("" : "+v"(row)); GAS bf16_t* rowp = Z + (size_t)row * DMIX + col0;
#pragma unroll
                for (int bj = 0; bj < 2; ++bj) *(GAS u32x4*)(rowp + bj * 128) = pack8(acc[ai][bj][m][0], acc[ai][bj][m][1]); }
    }
};
struct EpiRnn {
    static constexpr bool PERM = true, HAS_MID = false;
    const GAS float* ba; const GAS float* bx; const GAS bf16_t* XC; GAS bf16_t* Z; GAS bf16_t* PP;
    __device__ __forceinline__ void operator()(AccT& acc, const Unit& u, int wr, int wc, int fr, int fq) const {
        const int row0 = u.pm * 256 + wr * 64 + fr, ch0 = u.pn * 128 + wc * 32 + 8 * fq;
        f32x4 bav[2], bxv[2];
#pragma unroll
        for (int n = 0; n < 2; ++n) { bav[n] = *(const GAS f32x4*)(ba + ch0 + 4 * n); bxv[n] = *(const GAS f32x4*)(bx + ch0 + 4 * n); }
#pragma unroll
        for (int ai = 0; ai < 2; ++ai)
#pragma unroll
            for (int m = 0; m < 4; ++m) {
                int row = row0 + ai * 128 + m * 16; asm volatile("" : "+v"(row));
                const u32x4 xw = *(const GAS u32x4*)(XC + (size_t)row * DRNN + ch0);
                const f32x4 x0 = unpack4((u32x2){xw.x, xw.y}), x1 = unpack4((u32x2){xw.z, xw.w});
                const f32x4 r0 = sigmoid4(acc[ai][0][m][0] + bav[0]), r1 = sigmoid4(acc[ai][0][m][1] + bav[1]);
                const f32x4 i0 = sigmoid4(acc[ai][1][m][0] + bxv[0]), i1 = sigmoid4(acc[ai][1][m][1] + bxv[1]);
                *(GAS u32x4*)(Z + (size_t)row * DMIX + DPOOL + ch0) = pack8(r0, r1);
                *(GAS u32x4*)(PP + (size_t)row * DRNN + ch0) = pack8(i0 * x0, i1 * x1);
                asm volatile("" ::: "memory");
            }
    }
};
template <int SEG> struct EpiMrg {
    static constexpr bool PERM = false, HAS_MID = false;
    const GAS bf16_t* G; GAS float* MRG; GAS bf16_t* MB;
    __device__ __forceinline__ void operator()(AccT& acc, const Unit& u, int wr, int wc, int fr, int fq) const {
        const int row0 = u.pm * 256 + wr * 64 + fr, col0 = u.pn * 256 + wc * 32 + 4 * fq;
#pragma unroll
        for (int ai = 0; ai < 2; ++ai)
#pragma unroll
            for (int m = 0; m < 4; ++m) {
                int row = row0 + ai * 128 + m * 16; asm volatile("" : "+v"(row));
#pragma unroll
                for (int bj = 0; bj < 2; ++bj)
#pragma unroll
                    for (int n = 0; n < 2; ++n) {
                        const int c = col0 + bj * 128 + 16 * n;
                        const f32x4 g = unpack4(*(const GAS u32x2*)(G + (size_t)row * (3 * DM) + SEG * DM + c));
                        f32x4 v = g * acc[ai][bj][m][n]; GAS float* mp = MRG + (size_t)row * DM + c;
                        if (SEG == 0) *(GAS f32x4*)mp = v;
                        else if (SEG == 1) *(GAS f32x4*)mp = *(const GAS f32x4*)mp + v;
                        else { v = v + *(const GAS f32x4*)mp; *(GAS u32x2*)(MB + (size_t)row * DM + c) = pack4(v); }
                    }
                asm volatile("" ::: "memory");
            }
    }
};
struct EpiRes {
    static constexpr bool PERM = false, HAS_MID = false;
    const GAS float* baseP; const GAS float* baseS; GAS float* H; GAS bf16_t* HB; GAS float* ssq_out;
    __device__ __forceinline__ void operator()(AccT& acc, const Unit& u, int wr, int wc, int fr, int fq) const {
        const int row0 = u.pm * 256 + wr * 64 + fr, col0 = u.pn * 256 + wc * 32 + 4 * fq;
#pragma unroll
        for (int ai = 0; ai < 2; ++ai)
#pragma unroll
            for (int m = 0; m < 4; ++m) {
                int row = row0 + ai * 128 + m * 16; asm volatile("" : "+v"(row));
                const GAS float* bp = (row < MPR) ? baseP + (size_t)row * DM : baseS + (size_t)(row - MPR) * DM;
                float ss = 0.f;
#pragma unroll
                for (int bj = 0; bj < 2; ++bj)
#pragma unroll
                    for (int n = 0; n < 2; ++n) {
                        const int c = col0 + bj * 128 + 16 * n;
                        const f32x4 v = *(const GAS f32x4*)(bp + c) + acc[ai][bj][m][n];
                        *(GAS f32x4*)(H + (size_t)row * DM + c) = v; *(GAS u32x2*)(HB + (size_t)row * DM + c) = pack4(v);
                        ss += (v[0] * v[0] + v[1] * v[1]) + (v[2] * v[2] + v[3] * v[3]);
                    }
                ss += __shfl_xor(ss, 16); ss += __shfl_xor(ss, 32);
                if (fq == 0) ssq_out[(size_t)row * 16 + u.pn * 4 + wc] = ss;
                if (m & 1) asm volatile("" ::: "memory");
            }
    }
};
struct EpiUp {
    static constexpr bool PERM = true, HAS_MID = false;
    const GAS float* ssq; GAS bf16_t* GV;
    __device__ __forceinline__ void operator()(AccT& acc, const Unit& u, int wr, int wc, int fr, int fq) const {
        const int row0 = u.pm * 256 + wr * 64 + fr, col0 = u.pn * 256 + wc * 32 + 8 * fq;
#pragma unroll
        for (int ai = 0; ai < 2; ++ai)
#pragma unroll
            for (int m = 0; m < 4; ++m) {
                int row = row0 + ai * 128 + m * 16; asm volatile("" : "+v"(row)); const float rs = row_rs(ssq, row, fq);
                GAS bf16_t* rowp = GV + (size_t)row * (2 * DFF) + col0;
#pragma unroll
                for (int bj = 0; bj < 2; ++bj) *(GAS u32x4*)(rowp + bj * 128) = pack8(acc[ai][bj][m][0] * rs, acc[ai][bj][m][1] * rs);
            }
    }
};

struct EpiMrgR {
    static constexpr bool PERM = true, HAS_MID = true; static constexpr int SEAM1 = DPOOL / 64, SEAM2 = (DPOOL + DRNN) / 64;
    const GAS bf16_t* G; GAS bf16_t* MB;
    __device__ __forceinline__ void mid(AccT& acc, const Unit& u, int which, int wr, int wc, int fr, int fq) const {
        const int row0 = u.pm * 256 + wr * 64 + fr, col0 = u.pn * 256 + wc * 32 + 8 * fq;
        const int gnum = which * DM, gden = (which + 1) * DM;
#pragma unroll
        for (int ai = 0; ai < 2; ++ai)
#pragma unroll
            for (int m = 0; m < 4; ++m) {
                int row = row0 + ai * 128 + m * 16; asm volatile("" : "+v"(row));
                const GAS bf16_t* gp = G + (size_t)row * (3 * DM) + col0;
#pragma unroll
                for (int bj = 0; bj < 2; ++bj) {
                    const u32x4 a = *(const GAS u32x4*)(gp + gnum + bj * 128), b = *(const GAS u32x4*)(gp + gden + bj * 128);
                    const f32x4 a0 = unpack4((u32x2){a.x, a.y}), a1 = unpack4((u32x2){a.z, a.w}), b0 = unpack4((u32x2){b.x, b.y}), b1 = unpack4((u32x2){b.z, b.w});
                    f32x4 r0, r1;
#pragma unroll
                    for (int j = 0; j < 4; ++j) { r0[j] = a0[j] * __builtin_amdgcn_rcpf(fmaxf(b0[j], 1e-30f)); r1[j] = a1[j] * __builtin_amdgcn_rcpf(fmaxf(b1[j], 1e-30f)); }
                    acc[ai][bj][m][0] = acc[ai][bj][m][0] * r0; acc[ai][bj][m][1] = acc[ai][bj][m][1] * r1;
                }
                asm volatile("" ::: "memory");
            }
    }
    __device__ __forceinline__ void operator()(AccT& acc, const Unit& u, int wr, int wc, int fr, int fq) const {
        const int row0 = u.pm * 256 + wr * 64 + fr, col0 = u.pn * 256 + wc * 32 + 8 * fq;
#pragma unroll
        for (int ai = 0; ai < 2; ++ai)
#pragma unroll
            for (int m = 0; m < 4; ++m) {
                int row = row0 + ai * 128 + m * 16; asm volatile("" : "+v"(row));
                const GAS bf16_t* gp = G + (size_t)row * (3 * DM) + 2 * DM + col0; GAS bf16_t* op = MB + (size_t)row * DM + col0;
#pragma unroll
                for (int bj = 0; bj < 2; ++bj) {
                    const u32x4 a = *(const GAS u32x4*)(gp + bj * 128);
                    const f32x4 g0 = unpack4((u32x2){a.x, a.y}), g1 = unpack4((u32x2){a.z, a.w});
                    *(GAS u32x4*)(op + bj * 128) = pack8(acc[ai][bj][m][0] * g0, acc[ai][bj][m][1] * g1);
                }
                asm volatile("" ::: "memory");
            }
    }
};

struct Args { const GAS float* in[N_IN]; GAS float* out; GAS unsigned char* ws; int ph_lo, ph_hi; };
struct Ctx {
    LAS unsigned char* lds; int tid, lane, wave, G, bid;
    const GAS float* const CAS* in; GAS float* out; GAS unsigned char* ws;
};
#define WSP(T, off) ((GAS T*)(C.ws + (off)))
__device__ __forceinline__ int opq(int i) { asm volatile("" : "+s"(i)); return i; }

__device__ __forceinline__ void tr_item(const GAS float* W, int ldw, const GAS float* kscale, GAS bf16_t* WT, int ldk, int item, int nblk, LAS float* scr, int lane) {
    const int kb = item / nblk, nb = item % nblk, k0 = 64 * kb, n0 = 32 * nb;
#pragma unroll
    for (int i = 0; i < 8; ++i) { const int kk = 8 * i + (lane >> 3), n4 = (lane & 7) * 4; f32x4 w = *(const GAS f32x4*)(W + (size_t)(k0 + kk) * ldw + n0 + n4); if (kscale) w = w * kscale[k0 + kk];
        LAS float* d = scr + kk * 33 + n4; d[0] = w[0]; d[1] = w[1]; d[2] = w[2]; d[3] = w[3]; }
    LDS_WAIT(); asm volatile("" ::: "memory");
    const int c = lane & 7;
#pragma unroll
    for (int j = 0; j < 4; ++j) { const int n = (lane >> 3) + 8 * j; const LAS float* s = scr + (8 * c) * 33 + n;
        u32x4 o; o.x = cvt_pk_bf16(s[0 * 33], s[1 * 33]); o.y = cvt_pk_bf16(s[2 * 33], s[3 * 33]); o.z = cvt_pk_bf16(s[4 * 33], s[5 * 33]); o.w = cvt_pk_bf16(s[6 * 33], s[7 * 33]);
        *(GAS u32x4*)(WT + (size_t)(n0 + n) * ldk + k0 + 8 * c) = o; }
    LDS_WAIT(); asm volatile("" ::: "memory");
}
__device__ __forceinline__ void row_to_bf16_ssq(const GAS float* xrow, GAS bf16_t* orow, GAS float* ssq16, int lane) {
    const GAS f32x4* xr = (const GAS f32x4*)xrow + lane;
    f32x4 v[4]; float s = 0.f;
#pragma unroll
    for (int j = 0; j < 4; ++j) { v[j] = xr[64 * j]; s += (v[j][0] * v[j][0] + v[j][1] * v[j][1]) + (v[j][2] * v[j][2] + v[j][3] * v[j][3]); }
    s = wave_sum(s);
    GAS u32x2* o8 = (GAS u32x2*)orow + lane;
#pragma unroll
    for (int j = 0; j < 4; ++j) o8[64 * j] = pack4(v[j]);
    if (lane < 16) ssq16[lane] = (lane == 0) ? s : 0.f;
}
__device__ __forceinline__ void phase_prologue(const Ctx& C) {
    LAS float* scr = (LAS float*)(C.lds + RING_OFF + C.wave * 16384);
    const int gw = C.bid * NWAVES + C.wave, NGW = C.G * NWAVES;
    constexpr int PER_L = 9216;
    for (int it = gw; it < 2 * PER_L; it += NGW) {
        const int l = it / PER_L; int r = it % PER_L;
        const GAS float* W; const GAS float* ks = nullptr; GAS bf16_t* dst; int N, ldk;
        if (r < 1024)      { W = C.in[opq(I_WIN)] + (size_t)l * DM * DMIX; N = DMIX; ks = C.in[opq(I_GMIX)] + l * DM; dst = WSP(bf16_t, WS_W1) + (size_t)l * 5120 * DM; ldk = DM; }
        else if (r < 2560) { r -= 1024; W = C.in[opq(I_WGATE)] + (size_t)l * DM * 3 * DM; N = 3 * DM; ks = C.in[opq(I_GMIX)] + l * DM; dst = WSP(bf16_t, WS_W1) + ((size_t)l * 5120 + 2048) * DM; ldk = DM; }
        else if (r < 2816) { r -= 2560; W = C.in[opq(I_WK)] + (size_t)l * DM * DQ; N = DQ; ks = C.in[opq(I_GMEM)] + l * DM; dst = WSP(bf16_t, WS_WKV) + ((size_t)l * 1024) * DM; ldk = DM; }
        else if (r < 3072) { r -= 2816; W = C.in[opq(I_WV)] + (size_t)l * DM * DQ; N = DQ; ks = C.in[opq(I_GMEM)] + l * DM; dst = WSP(bf16_t, WS_WKV) + ((size_t)l * 1024 + 512) * DM; ldk = DM; }
        else if (r < 3328) { r -= 3072; W = C.in[opq(I_WBP)] + (size_t)l * DPOOL * DM; N = DM; dst = WSP(bf16_t, WS_WBR) + (size_t)l * DM * DMIX; ldk = DMIX; }
        else if (r < 3840) { r -= 3328; W = C.in[opq(I_WBR)] + (size_t)l * DRNN * DM; N = DM; dst = WSP(bf16_t, WS_WBR) + (size_t)l * DM * DMIX + 512; ldk = DMIX; }
        else if (r < 4096) { r -= 3840; W = C.in[opq(I_WBA)] + (size_t)l * DQ * DM; N = DM; dst = WSP(bf16_t, WS_WBR) + (size_t)l * DM * DMIX + 1536; ldk = DMIX; }
        else if (r < 4608) { r -= 4096; W = C.in[opq(I_WOUT)] + (size_t)l * DM * DM; N = DM; dst = WSP(bf16_t, WS_WOUT) + (size_t)l * DM * DM; ldk = DM; }
        else if (r < 7680) { r -= 4608; W = C.in[opq(I_WUP)] + (size_t)l * DM * 2 * DFF; N = 2 * DFF; ks = C.in[opq(I_GFFN)] + l * DM; dst = WSP(bf16_t, WS_WUP) + (size_t)l * 2 * DFF * DM; ldk = DM; }
        else               { r -= 7680; W = C.in[opq(I_WDOWN)] + (size_t)l * DFF * DM; N = DM; dst = WSP(bf16_t, WS_WDOWN) + (size_t)l * DM * DFF; ldk = DFF; }
        tr_item(W, N, ks, dst, ldk, r, N / 32, scr, C.lane);
    }
    const int gt = C.bid * NTHR + C.tid, NT = C.G * NTHR;
    {
        GAS bf16_t* PBD = WSP(bf16_t, WS_PBD); const GAS float* pw = C.in[opq(I_POOLW)]; const GAS float* ps = C.in[opq(I_POOLS)];
        for (int i = gt; i < 2 * 2 * 256 * 256; i += NT) {
            const int k = i & 255, n = (i >> 8) & 255, pn = (i >> 16) & 1, l = i >> 17;
            const int gn = 2 * pn + (n >> 7), gk = 2 * pn + (k >> 7);
            float v = 0.f;
            if (gn == gk) v = pw[(((size_t)l * 4 + gn) * 128 + (k & 127)) * 128 + (n & 127)] * ps[l * DPOOL + gn * 128 + (n & 127)];
            PBD[i] = (bf16_t)(cvt_pk_bf16(v, 0.f) & 0xffffu);
        }
        GAS bf16_t* RW = WSP(bf16_t, WS_RW); const GAS float* wa = C.in[opq(I_RWA)]; const GAS float* wx = C.in[opq(I_RWX)];
        for (int i = gt; i < 2 * 8 * 256 * 128; i += NT) {
            const int k = i & 127, n = (i >> 7) & 255, lb = i >> 15;
            const float v = (n < 128) ? wa[((size_t)lb * 128 + k) * 128 + n] : wx[((size_t)lb * 128 + k) * 128 + (n - 128)];
            RW[i] = (bf16_t)(cvt_pk_bf16(v, 0.f) & 0xffffu);
        }
    }
    for (int m = gw; m < MT + MEMROWS; m += NGW) {
        if (m < MT) { const GAS float* xr = (m < MPR) ? C.in[opq(I_XP)] + (size_t)m * DM : C.in[opq(I_XS)] + (size_t)(m - MPR) * DM;
            row_to_bf16_ssq(xr, WSP(bf16_t, WS_HB) + (size_t)m * DM, WSP(float, WS_SSQ1) + (size_t)m * 16, C.lane); }
        else { const int r = m - MT; row_to_bf16_ssq(C.in[opq(I_MEM)] + (size_t)r * DM, WSP(bf16_t, WS_MEMB) + (size_t)r * DM, WSP(float, WS_SSQM) + (size_t)r * 16, C.lane); }
    }
}

constexpr float ATT_C = 0.08838834764831845f * 1.4426950408889634f;
__device__ __forceinline__ void attn16_full(const GAS bf16_t* qrow, const GAS bf16_t* Kb, int ldk, const GAS bf16_t* VT, GAS bf16_t* orow, int lane) {
    const int q = lane & 15, g = lane >> 4;
    bf16x8 qf[4];
#pragma unroll
    for (int ks = 0; ks < 4; ++ks) qf[ks] = *(const GAS bf16x8*)(qrow + 32 * ks + 8 * g);
    f32x4 s[16];
    const GAS bf16_t* kr = Kb + (size_t)q * ldk + 8 * g;
#pragma unroll
    for (int t = 0; t < 16; ++t) {
        asm volatile("" : "+v"(kr));
        f32x4 a = (f32x4){0.f, 0.f, 0.f, 0.f};
#pragma unroll
        for (int ks = 0; ks < 4; ++ks) a = __builtin_amdgcn_mfma_f32_16x16x32_bf16(*(const GAS bf16x8*)(kr + 32 * ks), qf[ks], a, 0, 0, 0);
        s[t] = a;
        kr += (size_t)16 * ldk;
    }
    float mx = -3.0e38f;
#pragma unroll
    for (int t = 0; t < 16; ++t) mx = fmaxf(fmaxf(fmaxf(mx, s[t][0]), fmaxf(s[t][1], s[t][2])), s[t][3]);
    mx = fmaxf(mx, __shfl_xor(mx, 16)); mx = fmaxf(mx, __shfl_xor(mx, 32));
    float sum = 0.f;
#pragma unroll
    for (int t = 0; t < 16; ++t)
#pragma unroll
        for (int r = 0; r < 4; ++r) { const float p = __builtin_amdgcn_exp2f((s[t][r] - mx) * ATT_C); s[t][r] = p; sum += p; }
    sum += __shfl_xor(sum, 16); sum += __shfl_xor(sum, 32);
    const float inv = 1.0f / sum;
    bf16x8 pf[8];
#pragma unroll
    for (int ks = 0; ks < 8; ++ks) { const u32x4 w = pack8(s[2 * ks], s[2 * ks + 1]); pf[ks] = __builtin_bit_cast(bf16x8, w); }
    const GAS bf16_t* vr = VT + (size_t)q * NMEM + 4 * g; GAS bf16_t* op = orow + 4 * g;
#pragma unroll
    for (int nt = 0; nt < 8; ++nt) {
        asm volatile("" : "+v"(vr), "+v"(op));
        f32x4 o = (f32x4){0.f, 0.f, 0.f, 0.f};
#pragma unroll
        for (int ks = 0; ks < 8; ++ks) {
            const u32x2 lo = *(const GAS u32x2*)(vr + 32 * ks), hi = *(const GAS u32x2*)(vr + 32 * ks + 16);
            const u32x4 w = (u32x4){lo.x, lo.y, hi.x, hi.y};
            o = __builtin_amdgcn_mfma_f32_16x16x32_bf16(__builtin_bit_cast(bf16x8, w), pf[ks], o, 0, 0, 0);
        }
        *(GAS u32x2*)op = pack4(o * inv);
        vr += 16 * NMEM; op += 16;
    }
}
__device__ __forceinline__ void phase_attention(const Ctx& C, int l) {
    GAS bf16_t* Z = WSP(bf16_t, WS_Z);
    for (int id = C.bid; id < 256; id += C.G) {
        const int x = id & 7, j = id >> 3, pair = x * 4 + (j & 3), qb = j >> 2, b = pair >> 2, h = pair & 3;
        const GAS bf16_t* Kb = WSP(bf16_t, WS_KVB) + ((size_t)l * MEMROWS + b * NMEM) * 512 + h * HDIM;
        const GAS bf16_t* VT = WSP(bf16_t, WS_VTB) + (((size_t)l * NBP + b) * NHEAD + h) * HDIM * NMEM;
#pragma unroll 1
        for (int kb = 0; kb < 2; ++kb) {
            const int row = b * TP + qb * 256 + C.wave * 32 + kb * 16 + (C.lane & 15);
            GAS bf16_t* qp = Z + (size_t)row * DMIX + (DPOOL + DRNN) + h * HDIM;
            attn16_full(qp, Kb, 512, VT, qp, C.lane);
        }
    }
    LAS float* ML = (LAS float*)(C.lds + RING_OFF);
    LAS float* OP = (LAS float*)(C.lds + RING_OFF + 1024);
    for (int id = C.bid; id < NBS * NHEAD; id += C.G) {
        const int b = id >> 2, h = id & 3, w = C.wave, q = C.lane & 15, g = C.lane >> 4;
        const GAS float* Kc = C.in[opq(I_CK)] + ((((size_t)l * NBS + b) * NMEM) * NHEAD + h) * HDIM;
        const GAS float* Vc = C.in[opq(I_CV)] + ((((size_t)l * NBS + b) * NMEM) * NHEAD + h) * HDIM;
        const GAS bf16_t* qrow = Z + (size_t)(MPR + b * TS + (q & 7)) * DMIX + (DPOOL + DRNN) + h * HDIM;
        bf16x8 qf[4];
#pragma unroll
        for (int ks = 0; ks < 4; ++ks) qf[ks] = *(const GAS bf16x8*)(qrow + 32 * ks + 8 * g);
        f32x4 s[2];
#pragma unroll
        for (int t = 0; t < 2; ++t) {
            f32x4 a = (f32x4){0.f, 0.f, 0.f, 0.f}; const GAS float* kr = Kc + (size_t)(32 * w + 16 * t + q) * (NHEAD * HDIM) + 8 * g;
#pragma unroll
            for (int ks = 0; ks < 4; ++ks) { const u32x4 kw = pack8(*(const GAS f32x4*)(kr + 32 * ks), *(const GAS f32x4*)(kr + 32 * ks + 4));
                a = __builtin_amdgcn_mfma_f32_16x16x32_bf16(__builtin_bit_cast(bf16x8, kw), qf[ks], a, 0, 0, 0); }
            s[t] = a;
        }
        float mx = fmaxf(fmaxf(fmaxf(s[0][0], s[0][1]), fmaxf(s[0][2], s[0][3])), fmaxf(fmaxf(s[1][0], s[1][1]), fmaxf(s[1][2], s[1][3])));
        mx = fmaxf(mx, __shfl_xor(mx, 16)); mx = fmaxf(mx, __shfl_xor(mx, 32));
        float sum = 0.f;
#pragma unroll
        for (int t = 0; t < 2; ++t)
#pragma unroll
            for (int r = 0; r < 4; ++r) { const float p = __builtin_amdgcn_exp2f((s[t][r] - mx) * ATT_C); s[t][r] = p; sum += p; }
        sum += __shfl_xor(sum, 16); sum += __shfl_xor(sum, 32);
        const u32x4 pw = pack8(s[0], s[1]); const bf16x8 pf = __builtin_bit_cast(bf16x8, pw);
        if (g == 0) { ML[(w * 16 + q) * 2 + 0] = mx; ML[(w * 16 + q) * 2 + 1] = sum; }
        const GAS float* vr = Vc + (size_t)(32 * w + 4 * g) * (NHEAD * HDIM) + q;
#pragma unroll
        for (int nt = 0; nt < 8; ++nt) {
            asm volatile("" : "+v"(vr));
            const GAS float* v0p = vr; const GAS float* v1p = vr + 2 * (NHEAD * HDIM); const GAS float* v2p = vr + 16 * (NHEAD * HDIM); const GAS float* v3p = vr + 18 * (NHEAD * HDIM);
            float v[8];
            v[0] = v0p[0]; v[1] = v0p[NHEAD * HDIM]; v[2] = v1p[0]; v[3] = v1p[NHEAD * HDIM];
            v[4] = v2p[0]; v[5] = v2p[NHEAD * HDIM]; v[6] = v3p[0]; v[7] = v3p[NHEAD * HDIM];
            vr += 16;
            u32x4 vw; vw.x = cvt_pk_bf16(v[0], v[1]); vw.y = cvt_pk_bf16(v[2], v[3]); vw.z = cvt_pk_bf16(v[4], v[5]); vw.w = cvt_pk_bf16(v[6], v[7]);
            const f32x4 o = __builtin_amdgcn_mfma_f32_16x16x32_bf16(__builtin_bit_cast(bf16x8, vw), pf, (f32x4){0.f, 0.f, 0.f, 0.f}, 0, 0, 0);
            if (q < 8) *(LAS f32x4*)(OP + (w * 8 + q) * 128 + 16 * nt + 4 * g) = o;
        }
        __syncthreads();
        {
            const int qo = C.tid >> 6, d2 = (C.tid & 63) * 2;
            float mw[8], M = -3.0e38f;
#pragma unroll
            for (int ww = 0; ww < 8; ++ww) { mw[ww] = ML[(ww * 16 + qo) * 2]; M = fmaxf(M, mw[ww]); }
            float L = 0.f, o0 = 0.f, o1 = 0.f;
#pragma unroll
            for (int ww = 0; ww < 8; ++ww) { const float f = __builtin_amdgcn_exp2f((mw[ww] - M) * ATT_C); L += f * ML[(ww * 16 + qo) * 2 + 1];
                const f32x2 ov = *(const LAS f32x2*)(OP + (ww * 8 + qo) * 128 + d2); o0 += f * ov[0]; o1 += f * ov[1]; }
            const float inv = 1.0f / L;
            *(GAS unsigned*)(Z + (size_t)(MPR + b * TS + qo) * DMIX + (DPOOL + DRNN) + h * HDIM + d2) = cvt_pk_bf16(o0 * inv, o1 * inv);
        }
        __syncthreads();
    }
}

__device__ __forceinline__ void ld8(const GAS bf16_t* p, float (&v)[8]) { const u32x4 w = *(const GAS u32x4*)p; v[0] = bf_lo(w.x); v[1] = bf_hi(w.x); v[2] = bf_lo(w.y); v[3] = bf_hi(w.y); v[4] = bf_lo(w.z); v[5] = bf_hi(w.z); v[6] = bf_lo(w.w); v[7] = bf_hi(w.w); }
__device__ __forceinline__ void ld8f(const GAS float* p, float (&v)[8]) { const f32x4 a = *(const GAS f32x4*)p, b = *(const GAS f32x4*)(p + 4); v[0] = a[0]; v[1] = a[1]; v[2] = a[2]; v[3] = a[3]; v[4] = b[0]; v[5] = b[1]; v[6] = b[2]; v[7] = b[3]; }
__device__ __forceinline__ void st8(GAS bf16_t* p, const float (&v)[8]) { u32x4 w; w.x = cvt_pk_bf16(v[0], v[1]); w.y = cvt_pk_bf16(v[2], v[3]); w.z = cvt_pk_bf16(v[4], v[5]); w.w = cvt_pk_bf16(v[6], v[7]); *(GAS u32x4*)p = w; }
__device__ __forceinline__ void st8f(GAS float* p, const float (&v)[8]) { *(GAS f32x4*)p = (f32x4){v[0], v[1], v[2], v[3]}; *(GAS f32x4*)(p + 4) = (f32x4){v[4], v[5], v[6], v[7]}; }

__device__ __forceinline__ void phase_mix_elem(const Ctx& C, int l) {
    const GAS bf16_t* Z = WSP(bf16_t, WS_Z); GAS bf16_t* DBf = WSP(bf16_t, WS_DB); GAS bf16_t* XC = WSP(bf16_t, WS_XC);
    const GAS float* spool = C.in[opq(I_SPOOL)] + (size_t)l * NBS * 15 * DPOOL; const GAS float* srconv = C.in[opq(I_SRC)] + (size_t)l * NBS * 3 * DRNN;
    const GAS float* cw = C.in[opq(I_RCW)] + (size_t)l * 4 * DRNN; const GAS float* cb = C.in[opq(I_RCB)] + (size_t)l * DRNN;
    GAS float* out = C.out;
    const long total = (long)MT * 192;
    for (long idx = (long)C.bid * NTHR + C.tid; idx < total; idx += (long)C.G * NTHR) {
        const int m = (int)(idx / 192), c8 = (int)(idx % 192);
        const bool pr = m < MPR; const int b = pr ? (m >> 11) : ((m - MPR) >> 3), t = pr ? (m & 2047) : ((m - MPR) & 7);
        if (c8 < 64) {
            const int ch = c8 * 8, g = ch >> 7, w = 2 << g;
            float u[8], sum[8]; ld8(Z + (size_t)m * DMIX + ch, u);
#pragma unroll
            for (int i = 0; i < 8; ++i) sum[i] = u[i];
            for (int j = 1; j < w; ++j) { const int tt = t - j; float v[8];
                if (tt >= 0) { ld8(Z + (size_t)(m - j) * DMIX + ch, v); } else if (!pr) { ld8f(spool + ((size_t)b * 15 + (15 + tt)) * DPOOL + ch, v); } else break;
#pragma unroll
                for (int i = 0; i < 8; ++i) sum[i] += v[i]; }
            const float cnt = pr ? (float)((t + 1 < w) ? t + 1 : w) : (float)w; const float ic = 1.0f / cnt;
            float d[8];
#pragma unroll
            for (int i = 0; i < 8; ++i) d[i] = sum[i] * ic - u[i];
            st8(DBf + (size_t)m * DPOOL + ch, d);
            if (pr) { if (t >= TP - 15) st8f(out + O_PPOOL + (((size_t)l * NBP + b) * 15 + (t - (TP - 15))) * DPOOL + ch, u); }
            else { st8f(out + O_SPOOL + (((size_t)l * NBS + b) * 15 + 7 + t) * DPOOL + ch, u);
                if (t == 0) for (int j = 0; j < 7; ++j) { float v[8]; ld8f(spool + ((size_t)b * 15 + j + 8) * DPOOL + ch, v); st8f(out + O_SPOOL + (((size_t)l * NBS + b) * 15 + j) * DPOOL + ch, v); } }
        } else {
            const int ch = (c8 - 64) * 8;
            float x[8], u[8]; ld8f(cb + ch, x);
#pragma unroll
            for (int j = 0; j < 4; ++j) { const int tt = t + j - 3; float v[8], wj[8]; bool have = true;
                if (tt >= 0) ld8(Z + (size_t)(m + j - 3) * DMIX + DPOOL + ch, v); else if (!pr) ld8f(srconv + ((size_t)b * 3 + (3 + tt)) * DRNN + ch, v); else have = false;
                if (have) { ld8f(cw + (size_t)j * DRNN + ch, wj);
#pragma unroll
                    for (int i = 0; i < 8; ++i) x[i] += wj[i] * v[i]; }
                if (j == 3) {
#pragma unroll
                    for (int i = 0; i < 8; ++i) u[i] = v[i]; } }
            st8(XC + (size_t)m * DRNN + ch, x);
            if (pr) { if (t >= TP - 3) st8f(out + O_PRC + (((size_t)l * NBP + b) * 3 + (t - (TP - 3))) * DRNN + ch, u); }
            else { if (t >= TS - 3) st8f(out + O_SRC + (((size_t)l * NBS + b) * 3 + (t - (TS - 3))) * DRNN + ch, u); }
        }
    }
}

__device__ __forceinline__ void scan_coef(const GAS float* lam, int ch, float (&nl)[4]) {
#pragma unroll
    for (int i = 0; i < 4; ++i) { const float x = -lam[ch + i]; const float sp = fmaxf(x, 0.f) + log1pf(__expf(-fabsf(x))); nl[i] = -8.0f * 1.4426950408889634f * sp; }
}
__device__ __forceinline__ void scan_step(const GAS bf16_t* Zr, const GAS bf16_t* Pr, const float (&nl)[4], float (&h)[4], float (*A)[4]) {
    const f32x4 r = unpack4(*(const GAS u32x2*)Zr), p = unpack4(*(const GAS u32x2*)Pr);
#pragma unroll
    for (int i = 0; i < 4; ++i) { const float a = __builtin_amdgcn_exp2f(r[i] * nl[i]); const float beta = __builtin_amdgcn_sqrtf(fmaxf(1.0f - a * a, 0.f));
        h[i] = a * h[i] + beta * p[i]; if (A) (*A)[i] *= a; }
}
__device__ __forceinline__ void phase_scan_a(const Ctx& C, int l) {
    GAS bf16_t* Z = WSP(bf16_t, WS_Z); const GAS bf16_t* PP = WSP(bf16_t, WS_PP); GAS float* AGG = WSP(float, WS_AGG);
    const GAS float* lam = C.in[opq(I_LAM)] + (size_t)l * DRNN;
    for (int gt = C.bid * NTHR + C.tid; gt < NBP * 64 * 256; gt += C.G * NTHR) {
        const int unit = gt >> 8, ch = (gt & 255) * 4, b = unit >> 6, c = unit & 63;
        float nl[4]; scan_coef(lam, ch, nl);
        float h[4] = {0.f, 0.f, 0.f, 0.f}, A[4] = {1.f, 1.f, 1.f, 1.f};
        const size_t row0 = (size_t)b * TP + c * 32;
#pragma unroll 4
        for (int t = 0; t < 32; ++t) scan_step(Z + (row0 + t) * DMIX + DPOOL + ch, PP + (row0 + t) * DRNN + ch, nl, h, &A);
        *(GAS f32x4*)(AGG + ((size_t)(b * 64 + c)) * DRNN + ch) = (f32x4){A[0], A[1], A[2], A[3]};
        *(GAS f32x4*)(AGG + (size_t)NBP * 64 * DRNN + ((size_t)(b * 64 + c)) * DRNN + ch) = (f32x4){h[0], h[1], h[2], h[3]};
    }
    for (int gt = C.bid * NTHR + C.tid; gt < NBS * 256; gt += C.G * NTHR) {
        const int b = gt >> 8, ch = (gt & 255) * 4;
        float nl[4]; scan_coef(lam, ch, nl);
        const f32x4 h0 = *(const GAS f32x4*)(C.in[opq(I_SRH)] + ((size_t)l * NBS + b) * DRNN + ch);
        float h[4] = {h0[0], h0[1], h0[2], h0[3]};
        const size_t row0 = (size_t)MPR + b * TS;
#pragma unroll
        for (int t = 0; t < TS; ++t) { scan_step(Z + (row0 + t) * DMIX + DPOOL + ch, PP + (row0 + t) * DRNN + ch, nl, h, nullptr);
            *(GAS u32x2*)(Z + (row0 + t) * DMIX + DPOOL + ch) = pack4((f32x4){h[0], h[1], h[2], h[3]}); }
        *(GAS f32x4*)(C.out + O_SRH + ((size_t)l * NBS + b) * DRNN + ch) = (f32x4){h[0], h[1], h[2], h[3]};
    }
}
__device__ __forceinline__ void phase_scan_b(const Ctx& C, int l) {
    GAS bf16_t* Z = WSP(bf16_t, WS_Z); const GAS bf16_t* PP = WSP(bf16_t, WS_PP); const GAS float* AGG = WSP(float, WS_AGG);
    const GAS float* lam = C.in[opq(I_LAM)] + (size_t)l * DRNN;
    for (int gt = C.bid * NTHR + C.tid; gt < NBP * 64 * 256; gt += C.G * NTHR) {
        const int unit = gt >> 8, ch = (gt & 255) * 4, b = unit >> 6, c = unit & 63;
        float nl[4]; scan_coef(lam, ch, nl);
        float h[4] = {0.f, 0.f, 0.f, 0.f};
        for (int cc = 0; cc < c; ++cc) {
            const f32x4 a = *(const GAS f32x4*)(AGG + ((size_t)(b * 64 + cc)) * DRNN + ch), bb = *(const GAS f32x4*)(AGG + (size_t)NBP * 64 * DRNN + ((size_t)(b * 64 + cc)) * DRNN + ch);
#pragma unroll
            for (int i = 0; i < 4; ++i) h[i] = a[i] * h[i] + bb[i];
        }
        const size_t row0 = (size_t)b * TP + c * 32;
#pragma unroll 4
        for (int t = 0; t < 32; ++t) { scan_step(Z + (row0 + t) * DMIX + DPOOL + ch, PP + (row0 + t) * DRNN + ch, nl, h, nullptr);
            *(GAS u32x2*)(Z + (row0 + t) * DMIX + DPOOL + ch) = pack4((f32x4){h[0], h[1], h[2], h[3]}); }
        if (c == 63) *(GAS f32x4*)(C.out + O_PRH + ((size_t)l * NBP + b) * DRNN + ch) = (f32x4){h[0], h[1], h[2], h[3]};
    }
}

__device__ __forceinline__ float gelu_tanh(float x) { const float y = 0.7978845608028654f * (x + 0.044715f * x * x * x); return x * sigmoidf_(2.0f * y); }
__device__ __forceinline__ void phase_ffn_elem(const Ctx& C, int l) {
    const GAS bf16_t* GV = WSP(bf16_t, WS_GV); GAS bf16_t* ACT = WSP(bf16_t, WS_ACT);
    const GAS float* sfc = C.in[opq(I_SFC)] + (size_t)l * NBS * 2 * DFF; const GAS float* cw = C.in[opq(I_FCW)] + (size_t)l * 3 * DFF; const GAS float* cb = C.in[opq(I_FCB)] + (size_t)l * DFF;
    GAS float* out = C.out;
    const long total = (long)MT * 384;
    for (long idx = (long)C.bid * NTHR + C.tid; idx < total; idx += (long)C.G * NTHR) {
        const int m = (int)(idx / 384), ch = (int)(idx % 384) * 8;
        const bool pr = m < MPR; const int b = pr ? (m >> 11) : ((m - MPR) >> 3), t = pr ? (m & 2047) : ((m - MPR) & 7);
        float x[8], gp[8], val[8]; ld8f(cb + ch, x);
#pragma unroll
        for (int j = 0; j < 3; ++j) { const int tt = t + j - 2; float v[8], wj[8]; bool have = true;
            if (tt >= 0) ld8(GV + (size_t)(m + j - 2) * (2 * DFF) + ch, v); else if (!pr) ld8f(sfc + ((size_t)b * 2 + (2 + tt)) * DFF + ch, v); else have = false;
            if (have) { ld8f(cw + (size_t)j * DFF + ch, wj);
#pragma unroll
                for (int i = 0; i < 8; ++i) x[i] += wj[i] * v[i]; }
            if (j == 2) {
#pragma unroll
                for (int i = 0; i < 8; ++i) gp[i] = v[i]; } }
        ld8(GV + (size_t)m * (2 * DFF) + DFF + ch, val);
        float a[8];
#pragma unroll
        for (int i = 0; i < 8; ++i) a[i] = gelu_tanh(x[i]) * val[i];
        st8(ACT + (size_t)m * DFF + ch, a);
        if (pr) { if (t >= TP - 2) st8f(out + O_PFC + (((size_t)l * NBP + b) * 2 + (t - (TP - 2))) * DFF + ch, gp); }
        else { if (t >= TS - 2) st8f(out + O_SFC + (((size_t)l * NBS + b) * 2 + (t - (TS - 2))) * DFF + ch, gp); }
    }
}

__device__ __forceinline__ void phase_final(const Ctx& C) {
    const GAS float* H = WSP(float, WS_H); const GAS float* ssq = WSP(float, WS_SSQ1); const GAS float* gf = C.in[opq(I_GFIN)];
    const int gw = C.bid * NWAVES + C.wave, NGW = C.G * NWAVES;
    for (int m = gw; m < MT; m += NGW) {
        const GAS f32x4* sp = (const GAS f32x4*)(ssq + (size_t)m * 16);
        const f32x4 p0 = sp[0], p1 = sp[1], p2 = sp[2], p3 = sp[3];
        const float s = ((p0[0] + p0[1]) + (p0[2] + p0[3])) + ((p1[0] + p1[1]) + (p1[2] + p1[3])) + ((p2[0] + p2[1]) + (p2[2] + p2[3])) + ((p3[0] + p3[1]) + (p3[2] + p3[3]));
        const float rs = rsqrtf(s * (1.0f / 1024.0f) + EPSN);
        const GAS f32x4* hr = (const GAS f32x4*)(H + (size_t)m * DM) + C.lane; const GAS f32x4* gr = (const GAS f32x4*)gf + C.lane; GAS f32x4* orow = (GAS f32x4*)(C.out + O_Y + (size_t)m * DM) + C.lane;
#pragma unroll
        for (int j = 0; j < 4; ++j) orow[64 * j] = hr[64 * j] * rs * gr[64 * j];
    }
}

#ifndef OPT_FFN
#define OPT_FFN 1
#endif
#ifndef OPT_MIX
#define OPT_MIX 1
#endif
#ifndef OPT_ATTN
#define OPT_ATTN 1
#endif

__device__ __forceinline__ void phase_ffn_elem2(const Ctx& C, int l) {
    const GAS bf16_t* GV = WSP(bf16_t, WS_GV); GAS bf16_t* ACT = WSP(bf16_t, WS_ACT);
    const GAS float* sfc = C.in[opq(I_SFC)] + (size_t)l * NBS * 2 * DFF; const GAS float* cw = C.in[opq(I_FCW)] + (size_t)l * 3 * DFF; const GAS float* cb = C.in[opq(I_FCB)] + (size_t)l * DFF;
    GAS float* out = C.out;
    const int total = (MT / 8) * 384;
    for (int idx = C.bid * NTHR + C.tid; idx < total; idx += C.G * NTHR) {
        const int run = idx / 384, ch = (idx - run * 384) * 8, m0 = run * 8;
        const bool pr = m0 < MPR; const int b = pr ? (m0 >> 11) : ((m0 - MPR) >> 3), t0 = pr ? (m0 & 2047) : 0;
        float bia[8], w0[8], w1[8], w2[8], gm2[8], gm1[8];
        ld8f(cb + ch, bia); ld8f(cw + ch, w0); ld8f(cw + DFF + ch, w1); ld8f(cw + 2 * DFF + ch, w2);
        if (pr) { if (t0 >= 2) { ld8(GV + (size_t)(m0 - 2) * (2 * DFF) + ch, gm2); ld8(GV + (size_t)(m0 - 1) * (2 * DFF) + ch, gm1); }
                  else {
#pragma unroll
                      for (int i = 0; i < 8; ++i) { gm2[i] = 0.f; gm1[i] = 0.f; } } }
        else { ld8f(sfc + ((size_t)b * 2 + 0) * DFF + ch, gm2); ld8f(sfc + ((size_t)b * 2 + 1) * DFF + ch, gm1); }
        u32x4 gw[8], vw[8];
#pragma unroll
        for (int r = 0; r < 8; ++r) { gw[r] = *(const GAS u32x4*)(GV + (size_t)(m0 + r) * (2 * DFF) + ch); vw[r] = *(const GAS u32x4*)(GV + (size_t)(m0 + r) * (2 * DFF) + DFF + ch); }
#pragma unroll
        for (int r = 0; r < 8; ++r) {
            float g[8], v[8], a[8];
            g[0] = bf_lo(gw[r].x); g[1] = bf_hi(gw[r].x); g[2] = bf_lo(gw[r].y); g[3] = bf_hi(gw[r].y); g[4] = bf_lo(gw[r].z); g[5] = bf_hi(gw[r].z); g[6] = bf_lo(gw[r].w); g[7] = bf_hi(gw[r].w);
            v[0] = bf_lo(vw[r].x); v[1] = bf_hi(vw[r].x); v[2] = bf_lo(vw[r].y); v[3] = bf_hi(vw[r].y); v[4] = bf_lo(vw[r].z); v[5] = bf_hi(vw[r].z); v[6] = bf_lo(vw[r].w); v[7] = bf_hi(vw[r].w);
#pragma unroll
            for (int i = 0; i < 8; ++i) { const float x = bia[i] + w0[i] * gm2[i] + w1[i] * gm1[i] + w2[i] * g[i]; a[i] = gelu_tanh(x) * v[i]; gm2[i] = gm1[i]; gm1[i] = g[i]; }
            st8(ACT + (size_t)(m0 + r) * DFF + ch, a);
            if (r >= 6) {
                if (pr) { if (t0 == TP - 8) st8f(out + O_PFC + (((size_t)l * NBP + b) * 2 + (r - 6)) * DFF + ch, g); }
                else st8f(out + O_SFC + (((size_t)l * NBS + b) * 2 + (r - 6)) * DFF + ch, g);
            }
        }
    }
}

__device__ __forceinline__ void phase_mix_elem2(const Ctx& C, int l) {
    const GAS bf16_t* Z = WSP(bf16_t, WS_Z); GAS bf16_t* DBf = WSP(bf16_t, WS_DB); GAS bf16_t* XC = WSP(bf16_t, WS_XC);
    const GAS float* spool = C.in[opq(I_SPOOL)] + (size_t)l * NBS * 15 * DPOOL; const GAS float* srconv = C.in[opq(I_SRC)] + (size_t)l * NBS * 3 * DRNN;
    const GAS float* cw = C.in[opq(I_RCW)] + (size_t)l * 4 * DRNN; const GAS float* cb = C.in[opq(I_RCB)] + (size_t)l * DRNN;
    GAS float* out = C.out;
    const int totalP = (MPR / 32) * 192;
    for (int idx = C.bid * NTHR + C.tid; idx < totalP; idx += C.G * NTHR) {
        const int run = idx / 192, c8 = idx - run * 192, m0 = run * 32, b = m0 >> 11, t0 = m0 & 2047;
        if (c8 < 64) {
            const int ch = c8 * 8, g = ch >> 7, w = 2 << g;
            float sum[8];
#pragma unroll
            for (int i = 0; i < 8; ++i) sum[i] = 0.f;
            for (int j = 1; j < w; ++j) { if (t0 - j < 0) break; float v[8]; ld8(Z + (size_t)(m0 - j) * DMIX + ch, v);
#pragma unroll
                for (int i = 0; i < 8; ++i) sum[i] += v[i]; }
            const float iw = 1.0f / (float)w;
#pragma unroll 4
            for (int r = 0; r < 32; ++r) {
                const int t = t0 + r; float u[8], d[8]; ld8(Z + (size_t)(m0 + r) * DMIX + ch, u);
                const float ic = (t + 1 < w) ? 1.0f / (float)(t + 1) : iw;
#pragma unroll
                for (int i = 0; i < 8; ++i) { sum[i] += u[i]; d[i] = sum[i] * ic - u[i]; }
                st8(DBf + (size_t)(m0 + r) * DPOOL + ch, d);
                if (t - w + 1 >= 0) { float o[8]; ld8(Z + (size_t)(m0 + r - w + 1) * DMIX + ch, o);
#pragma unroll
                    for (int i = 0; i < 8; ++i) sum[i] -= o[i]; }
                if (t >= TP - 15) st8f(out + O_PPOOL + (((size_t)l * NBP + b) * 15 + (t - (TP - 15))) * DPOOL + ch, u);
            }
        } else {
            const int ch = (c8 - 64) * 8;
            float bia[8], w0[8], w1[8], w2[8], w3[8], x3[8], x2[8], x1[8];
            ld8f(cb + ch, bia); ld8f(cw + ch, w0); ld8f(cw + DRNN + ch, w1); ld8f(cw + 2 * DRNN + ch, w2); ld8f(cw + 3 * DRNN + ch, w3);
            if (t0 >= 3) { ld8(Z + (size_t)(m0 - 3) * DMIX + DPOOL + ch, x3); ld8(Z + (size_t)(m0 - 2) * DMIX + DPOOL + ch, x2); ld8(Z + (size_t)(m0 - 1) * DMIX + DPOOL + ch, x1); }
            else {
#pragma unroll
                for (int i = 0; i < 8; ++i) { x3[i] = 0.f; x2[i] = 0.f; x1[i] = 0.f; } }
#pragma unroll 4
            for (int r = 0; r < 32; ++r) {
                const int t = t0 + r; float u[8], x[8]; ld8(Z + (size_t)(m0 + r) * DMIX + DPOOL + ch, u);
#pragma unroll
                for (int i = 0; i < 8; ++i) { x[i] = bia[i] + w0[i] * x3[i] + w1[i] * x2[i] + w2[i] * x1[i] + w3[i] * u[i]; x3[i] = x2[i]; x2[i] = x1[i]; x1[i] = u[i]; }
                st8(XC + (size_t)(m0 + r) * DRNN + ch, x);
                if (t >= TP - 3) st8f(out + O_PRC + (((size_t)l * NBP + b) * 3 + (t - (TP - 3))) * DRNN + ch, u);
            }
        }
    }
    const int totalS = MSA * 192;
    for (int idx = C.bid * NTHR + C.tid; idx < totalS; idx += C.G * NTHR) {
        const int ms = idx / 192, c8 = idx - ms * 192, m = MPR + ms, b = ms >> 3, t = ms & 7;
        if (c8 < 64) {
            const int ch = c8 * 8, g = ch >> 7, w = 2 << g;
            float u[8], sum[8]; ld8(Z + (size_t)m * DMIX + ch, u);
#pragma unroll
            for (int i = 0; i < 8; ++i) sum[i] = u[i];
            for (int j = 1; j < w; ++j) { const int tt = t - j; float v[8];
                if (tt >= 0) ld8(Z + (size_t)(m - j) * DMIX + ch, v); else ld8f(spool + ((size_t)b * 15 + (15 + tt)) * DPOOL + ch, v);
#pragma unroll
                for (int i = 0; i < 8; ++i) sum[i] += v[i]; }
            const float ic = 1.0f / (float)w; float d[8];
#pragma unroll
            for (int i = 0; i < 8; ++i) d[i] = sum[i] * ic - u[i];
            st8(DBf + (size_t)m * DPOOL + ch, d);
            st8f(out + O_SPOOL + (((size_t)l * NBS + b) * 15 + 7 + t) * DPOOL + ch, u);
            if (t == 0) for (int j = 0; j < 7; ++j) { float v[8]; ld8f(spool + ((size_t)b * 15 + j + 8) * DPOOL + ch, v); st8f(out + O_SPOOL + (((size_t)l * NBS + b) * 15 + j) * DPOOL + ch, v); }
        } else {
            const int ch = (c8 - 64) * 8;
            float x[8], u[8]; ld8f(cb + ch, x);
#pragma unroll
            for (int j = 0; j < 4; ++j) { const int tt = t + j - 3; float v[8], wj[8];
                if (tt >= 0) ld8(Z + (size_t)(m + j - 3) * DMIX + DPOOL + ch, v); else ld8f(srconv + ((size_t)b * 3 + (3 + tt)) * DRNN + ch, v);
                ld8f(cw + (size_t)j * DRNN + ch, wj);
#pragma unroll
                for (int i = 0; i < 8; ++i) x[i] += wj[i] * v[i];
                if (j == 3) {
#pragma unroll
                    for (int i = 0; i < 8; ++i) u[i] = v[i]; } }
            st8(XC + (size_t)m * DRNN + ch, x);
            if (t >= TS - 3) st8f(out + O_SRC + (((size_t)l * NBS + b) * 3 + (t - (TS - 3))) * DRNN + ch, u);
        }
    }
}

__device__ __forceinline__ void attn16_lds(const GAS bf16_t* qrow, LAS unsigned char* lds, GAS bf16_t* orow, int lane) {
    const int q = lane & 15, g = lane >> 4;
    bf16x8 qf[4];
#pragma unroll
    for (int ks = 0; ks < 4; ++ks) qf[ks] = *(const GAS bf16x8*)(qrow + 32 * ks + 8 * g);
    f32x4 s[16];
    const LAS unsigned char* kbase = lds + q * 256;
#pragma unroll
    for (int t = 0; t < 16; ++t) {
        f32x4 a = (f32x4){0.f, 0.f, 0.f, 0.f};
#pragma unroll
        for (int ks = 0; ks < 4; ++ks) a = __builtin_amdgcn_mfma_f32_16x16x32_bf16(*(const LAS bf16x8*)(kbase + t * 4096 + (((g + 4 * ks) ^ q) << 4)), qf[ks], a, 0, 0, 0);
        s[t] = a;
    }
    float mx = -3.0e38f;
#pragma unroll
    for (int t = 0; t < 16; ++t) mx = fmaxf(fmaxf(fmaxf(mx, s[t][0]), fmaxf(s[t][1], s[t][2])), s[t][3]);
    mx = fmaxf(mx, __shfl_xor(mx, 16)); mx = fmaxf(mx, __shfl_xor(mx, 32));
    float sum = 0.f;
#pragma unroll
    for (int t = 0; t < 16; ++t)
#pragma unroll
        for (int r = 0; r < 4; ++r) { const float p = __builtin_amdgcn_exp2f((s[t][r] - mx) * ATT_C); s[t][r] = p; sum += p; }
    sum += __shfl_xor(sum, 16); sum += __shfl_xor(sum, 32);
    const float inv = 1.0f / sum;
    bf16x8 pf[8];
#pragma unroll
    for (int ks = 0; ks < 8; ++ks) { const u32x4 w = pack8(s[2 * ks], s[2 * ks + 1]); pf[ks] = __builtin_bit_cast(bf16x8, w); }
    const LAS unsigned char* vbase = lds + 65536 + q * 512;
#pragma unroll
    for (int nt = 0; nt < 8; ++nt) {
        f32x4 o = (f32x4){0.f, 0.f, 0.f, 0.f};
#pragma unroll
        for (int ks = 0; ks < 8; ++ks) {
            const u32x2 lo = *(const LAS u32x2*)(vbase + nt * 8192 + (((8 * ks + g) ^ (4 * q)) << 3)), hi = *(const LAS u32x2*)(vbase + nt * 8192 + (((8 * ks + 4 + g) ^ (4 * q)) << 3));
            const u32x4 w = (u32x4){lo.x, lo.y, hi.x, hi.y};
            o = __builtin_amdgcn_mfma_f32_16x16x32_bf16(__builtin_bit_cast(bf16x8, w), pf[ks], o, 0, 0, 0);
        }
        *(GAS u32x2*)(orow + 16 * nt + 4 * g) = pack4(o * inv);
    }
}
__device__ __forceinline__ void phase_attention2(const Ctx& C, int l) {
    GAS bf16_t* Z = WSP(bf16_t, WS_Z);
    LAS unsigned char* lds = C.lds + RING_OFF;
    for (int id = C.bid; id < 256; id += C.G) {
        const int x = id & 7, j = id >> 3, pair = x * 4 + (j & 3), qb = j >> 2, b = pair >> 2, h = pair & 3;
        const GAS bf16_t* Kb = WSP(bf16_t, WS_KVB) + ((size_t)l * MEMROWS + b * NMEM) * 512 + h * HDIM;
        const GAS bf16_t* VT = WSP(bf16_t, WS_VTB) + (((size_t)l * NBP + b) * NHEAD + h) * HDIM * NMEM;
#pragma unroll
        for (int jj = 0; jj < 8; ++jj) { const int e = C.tid + NTHR * jj, row = e >> 4, c = e & 15;
            const u32x4 v = *(const GAS u32x4*)(Kb + (size_t)row * 512 + c * 8); *(LAS u32x4*)(lds + row * 256 + ((c ^ (row & 15)) << 4)) = v; }
#pragma unroll
        for (int jj = 0; jj < 8; ++jj) { const int e = C.tid + NTHR * jj, row = e >> 5, c16 = e & 31, c8s = (2 * c16) ^ (4 * (row & 15));
            const u32x4 v = *(const GAS u32x4*)(VT + (size_t)row * NMEM + c16 * 8); *(LAS u32x4*)(lds + 65536 + row * 512 + (c8s << 3)) = v; }
        __syncthreads();
#pragma unroll 1
        for (int kb = 0; kb < 2; ++kb) {
            const int row = b * TP + qb * 256 + C.wave * 32 + kb * 16 + (C.lane & 15);
            GAS bf16_t* qp = Z + (size_t)row * DMIX + (DPOOL + DRNN) + h * HDIM;
            attn16_lds(qp, lds, qp, C.lane);
        }
        __syncthreads();
    }
    LAS float* ML = (LAS float*)(lds);
    LAS float* PL = (LAS float*)(lds + 1024);
    LAS float* OP = (LAS float*)(lds + 16384);
    for (int id = C.bid; id < NBS * NHEAD; id += C.G) {
        const int b = id >> 2, h = id & 3, w = C.wave, q = C.lane & 15, g = C.lane >> 4;
        const GAS float* Kc = C.in[opq(I_CK)] + ((((size_t)l * NBS + b) * NMEM) * NHEAD + h) * HDIM;
        const GAS float* Vc = C.in[opq(I_CV)] + ((((size_t)l * NBS + b) * NMEM) * NHEAD + h) * HDIM;
        const GAS bf16_t* qrow = Z + (size_t)(MPR + b * TS + (q & 7)) * DMIX + (DPOOL + DRNN) + h * HDIM;
        bf16x8 qf[4];
#pragma unroll
        for (int ks = 0; ks < 4; ++ks) qf[ks] = *(const GAS bf16x8*)(qrow + 32 * ks + 8 * g);
        const int hw = C.lane >> 5, d4 = (C.lane & 31) * 4;
        f32x4 vv[16];
#pragma unroll
        for (int kk = 0; kk < 16; ++kk) vv[kk] = *(const GAS f32x4*)(Vc + (size_t)(32 * w + 2 * kk + hw) * (NHEAD * HDIM) + d4);
        f32x4 s[2];
#pragma unroll
        for (int t = 0; t < 2; ++t) {
            f32x4 a = (f32x4){0.f, 0.f, 0.f, 0.f}; const GAS float* kr = Kc + (size_t)(32 * w + 16 * t + q) * (NHEAD * HDIM) + 8 * g;
#pragma unroll
            for (int ks = 0; ks < 4; ++ks) { const u32x4 kw = pack8(*(const GAS f32x4*)(kr + 32 * ks), *(const GAS f32x4*)(kr + 32 * ks + 4));
                a = __builtin_amdgcn_mfma_f32_16x16x32_bf16(__builtin_bit_cast(bf16x8, kw), qf[ks], a, 0, 0, 0); }
            s[t] = a;
        }
        float mx = fmaxf(fmaxf(fmaxf(s[0][0], s[0][1]), fmaxf(s[0][2], s[0][3])), fmaxf(fmaxf(s[1][0], s[1][1]), fmaxf(s[1][2], s[1][3])));
        mx = fmaxf(mx, __shfl_xor(mx, 16)); mx = fmaxf(mx, __shfl_xor(mx, 32));
        float sum = 0.f;
#pragma unroll
        for (int t = 0; t < 2; ++t)
#pragma unroll
            for (int r = 0; r < 4; ++r) { const float p = __builtin_amdgcn_exp2f((s[t][r] - mx) * ATT_C); s[t][r] = p; sum += p; }
        sum += __shfl_xor(sum, 16); sum += __shfl_xor(sum, 32);
        if (g == 0) { ML[(w * 16 + q) * 2 + 0] = mx; ML[(w * 16 + q) * 2 + 1] = sum; }
        if (q < 8) {
#pragma unroll
            for (int t = 0; t < 2; ++t)
#pragma unroll
                for (int r = 0; r < 4; ++r) PL[(w * 32 + 16 * t + 4 * g + r) * 8 + q] = s[t][r];
        }
        LDS_WAIT(); __builtin_amdgcn_wave_barrier();
        f32x4 oacc[8];
#pragma unroll
        for (int qq = 0; qq < 8; ++qq) oacc[qq] = (f32x4){0.f, 0.f, 0.f, 0.f};
#pragma unroll
        for (int kk = 0; kk < 16; ++kk) {
            const LAS f32x4* pp = (const LAS f32x4*)(PL + (w * 32 + 2 * kk + hw) * 8);
            const f32x4 p0 = pp[0], p1 = pp[1];
            oacc[0] += vv[kk] * p0[0]; oacc[1] += vv[kk] * p0[1]; oacc[2] += vv[kk] * p0[2]; oacc[3] += vv[kk] * p0[3];
            oacc[4] += vv[kk] * p1[0]; oacc[5] += vv[kk] * p1[1]; oacc[6] += vv[kk] * p1[2]; oacc[7] += vv[kk] * p1[3];
        }
#pragma unroll
        for (int qq = 0; qq < 8; ++qq) *(LAS f32x4*)(OP + ((w * 2 + hw) * 8 + qq) * 128 + d4) = oacc[qq];
        __syncthreads();
        {
            const int qo = C.tid >> 6, d2 = (C.tid & 63) * 2;
            float mw[8], M = -3.0e38f;
#pragma unroll
            for (int ww = 0; ww < 8; ++ww) { mw[ww] = ML[(ww * 16 + qo) * 2]; M = fmaxf(M, mw[ww]); }
            float L = 0.f, o0 = 0.f, o1 = 0.f;
#pragma unroll
            for (int ww = 0; ww < 8; ++ww) { const float f = __builtin_amdgcn_exp2f((mw[ww] - M) * ATT_C); L += f * ML[(ww * 16 + qo) * 2 + 1];
                const f32x2 oa = *(const LAS f32x2*)(OP + ((ww * 2 + 0) * 8 + qo) * 128 + d2), ob = *(const LAS f32x2*)(OP + ((ww * 2 + 1) * 8 + qo) * 128 + d2);
                o0 += f * (oa[0] + ob[0]); o1 += f * (oa[1] + ob[1]); }
            const float inv = 1.0f / L;
            *(GAS unsigned*)(Z + (size_t)(MPR + b * TS + qo) * DMIX + (DPOOL + DRNN) + h * HDIM + d2) = cvt_pk_bf16(o0 * inv, o1 * inv);
        }
        __syncthreads();
    }
}

#define LDSR (C.lds + RING_OFF)
__device__ __forceinline__ int rot(const Ctx& C, int start) { return (C.bid + C.G - (start % C.G)) % C.G; }

__device__ __forceinline__ void phase_p1(const Ctx& C, int l) {
    { pg8::Gemm g{WSP(bf16_t, WS_HB), WSP(bf16_t, WS_W1) + (size_t)l * 5120 * DM, DM, DM, DM / 64, 0};
      pg8::StaticOrder S; S.init(MT / 256, 20, C.G, C.bid);
      EpiP1 E{WSP(float, WS_SSQ1), WSP(bf16_t, WS_Z), WSP(bf16_t, WS_G), C.in[opq(I_BGATE)] + (size_t)l * 3 * DM};
      pg8::gemm_phase<EpiP1, pg8::StaticOrder, true>(LDSR, C.wave, g, S, E); }
    if (l == 0) {
      pg8::Gemm g{WSP(bf16_t, WS_MEMB), WSP(bf16_t, WS_WKV), DM, DM, DM / 64, 0};
      pg8::StaticOrder S; S.init(MEMROWS / 256, 8, C.G, rot(C, (MT / 256) * 20));
      EpiKV E{WSP(float, WS_SSQM), C.out, WSP(bf16_t, WS_KVB), WSP(bf16_t, WS_VTB)};
      pg8::gemm_phase<EpiKV, pg8::StaticOrder, true>(LDSR, C.wave, g, S, E); }
}
__device__ __forceinline__ void phase_p2b(const Ctx& C, int l) {
    { pg8::Gemm g{WSP(bf16_t, WS_XC), WSP(bf16_t, WS_RW) + (size_t)l * 8 * 256 * 128, DRNN, 128, 2, 128};
      pg8::StaticOrder S; S.init(MT / 256, 8, C.G, C.bid);
      EpiRnn E{C.in[opq(I_RBA)] + (size_t)l * DRNN, C.in[opq(I_RBX)] + (size_t)l * DRNN, WSP(bf16_t, WS_XC), WSP(bf16_t, WS_Z), WSP(bf16_t, WS_PP)};
      pg8::gemm_phase<EpiRnn, pg8::StaticOrder, true>(LDSR, C.wave, g, S, E); }
    { pg8::Gemm g{WSP(bf16_t, WS_DB), WSP(bf16_t, WS_PBD) + (size_t)l * 2 * 256 * 256, DPOOL, 256, 4, 256};
      pg8::StaticOrder S; S.init(MT / 256, 2, C.G, rot(C, (MT / 256) * 8));
      EpiPool E{WSP(bf16_t, WS_Z)};
      pg8::gemm_phase<EpiPool, pg8::StaticOrder, true>(LDSR, C.wave, g, S, E); }
}
__device__ __forceinline__ void phase_p3(const Ctx& C, int l) {
    pg8::Gemm g{WSP(bf16_t, WS_Z), WSP(bf16_t, WS_WBR) + (size_t)l * DM * DMIX, DMIX, DMIX, DMIX / 64, 0};
    pg8::StaticOrder S; S.init(MT / 256, 4, C.G, C.bid);
    EpiMrgR E{WSP(bf16_t, WS_G), WSP(bf16_t, WS_MB)};
    pg8::gemm_phase<EpiMrgR, pg8::StaticOrder, true>(LDSR, C.wave, g, S, E);
}
__device__ __forceinline__ void phase_p4(const Ctx& C, int l) {
    pg8::Gemm g{WSP(bf16_t, WS_MB), WSP(bf16_t, WS_WOUT) + (size_t)l * DM * DM, DM, DM, DM / 64, 0};
    pg8::StaticOrder S; S.init(MT / 256, 4, C.G, C.bid);
    const GAS float* bP = (l == 0) ? C.in[opq(I_XP)] : WSP(float, WS_H); const GAS float* bS = (l == 0) ? C.in[opq(I_XS)] : WSP(float, WS_H) + (size_t)MPR * DM;
    EpiRes E{bP, bS, WSP(float, WS_H), WSP(bf16_t, WS_HB), WSP(float, WS_SSQ2)};
    pg8::gemm_phase<EpiRes, pg8::StaticOrder, true>(LDSR, C.wave, g, S, E);
}
__device__ __forceinline__ void phase_p5(const Ctx& C, int l) {
    pg8::Gemm g{WSP(bf16_t, WS_HB), WSP(bf16_t, WS_WUP) + (size_t)l * 2 * DFF * DM, DM, DM, DM / 64, 0};
    pg8::StaticOrder S; S.init(MT / 256, 24, C.G, C.bid);
    EpiUp E{WSP(float, WS_SSQ2), WSP(bf16_t, WS_GV)};
    pg8::gemm_phase<EpiUp, pg8::StaticOrder, true>(LDSR, C.wave, g, S, E);
}
__device__ __forceinline__ void phase_p7(const Ctx& C, int l) {
    pg8::Gemm g{WSP(bf16_t, WS_ACT), WSP(bf16_t, WS_WDOWN) + (size_t)l * DM * DFF, DFF, DFF, DFF / 64, 0};
    pg8::StaticOrder S; S.init(MT / 256, 4, C.G, C.bid);
    EpiRes E{WSP(float, WS_H), WSP(float, WS_H) + (size_t)MPR * DM, WSP(float, WS_H), WSP(bf16_t, WS_HB), WSP(float, WS_SSQ1)};
    pg8::gemm_phase<EpiRes, pg8::StaticOrder, true>(LDSR, C.wave, g, S, E);
}

constexpr int NPHASE = 22;
#ifndef MK_ONE_LAUNCH
#define MK_ONE_LAUNCH 1
#endif

__global__ void __launch_bounds__(NTHR, 2) fwd_kernel(Args args) {
    extern __shared__ __attribute__((aligned(16))) unsigned char lds_raw[];
    Ctx C;
    const int wave0 = __builtin_amdgcn_readfirstlane((int)threadIdx.x >> 6);
    C.lds = (LAS unsigned char*)lds_raw; C.tid = threadIdx.x; C.lane = C.tid & 63; C.wave = wave0;
    C.G = gridDim.x; C.bid = blockIdx.x; C.in = nullptr; C.out = args.out; C.ws = args.ws;
    volatile LAS unsigned* MISC = (volatile LAS unsigned*)(C.lds + MISC_OFF);
    for (int u = C.tid; u < (LDS_BYTES - LDSCTL_OFF) / 4; u += NTHR) ((LAS unsigned*)(C.lds + LDSCTL_OFF))[u] = 0u;
    __syncthreads();
    const int lo = args.ph_lo, hi = args.ph_hi;
    XcdBarrier bar; bar.bar = (unsigned*)(C.ws + WS_CTL) + CW_BAR; bar.x = 0; bar.st = nullptr;
    if (hi - lo > 1) bar = xcd_barrier_post((unsigned*)(C.ws + WS_CTL) + CW_BAR, MISC + 8);
#define PH_SETUP() do { int wave_ = wave0; asm volatile("" : "+s"(wave_)); const int lane_ = pg8::fresh_lane(); \
        C.in = (const GAS float* const CAS*)args.in; C.tid = wave_ * 64 + lane_; C.lane = lane_; C.wave = wave_; C.bid = blockIdx.x; C.ws = args.ws; C.out = args.out; } while (0)
#define PH_BAR(k) do { if ((k) + 1 < hi) { int w_ = wave0; asm volatile("" : "+s"(w_)); xcd_barrier(bar, w_ == 0 && pg8::fresh_lane() == 0); } } while (0)
#ifndef PROBE_MASK
#define PROBE_MASK 0u
#endif
#ifndef PROBE_SUB
#define PROBE_SUB 0
#endif
#ifndef PROBE_MULT
#define PROBE_MULT 4
#endif
    unsigned long long probe_acc = 0ull;
#define PH(k, body) do { if (lo <= (k) && (k) < hi) { unsigned long long t0_ = 0ull; if (PROBE_MASK != 0u) t0_ = __builtin_amdgcn_s_memrealtime(); PH_SETUP(); body; PH_BAR(k); \
        if ((PROBE_MASK >> (k)) & 1u) probe_acc += __builtin_amdgcn_s_memrealtime() - t0_; } } while (0)
#ifndef PHM
#define PHM 0xFFFF
#endif
    PH(0, if (PHM & 1) phase_prologue(C));
#define LAYER(l) do { const int pb = 1 + 10 * (l); \
        PH(pb + 0, if (PHM & 4) phase_p1(C, l)); \
        PH(pb + 1, if (PHM & 8) { if (OPT_ATTN) phase_attention2(C, l); else phase_attention(C, l); } if (PROBE_SUB == 1) probe_acc += __builtin_amdgcn_s_memrealtime() - t0_; if (PHM & 16) { if (OPT_MIX) phase_mix_elem2(C, l); else phase_mix_elem(C, l); }); \
        PH(pb + 2, if (PHM & 32) phase_p2b(C, l)); \
        PH(pb + 3, if (PHM & 64) phase_scan_a(C, l)); \
        PH(pb + 4, if (PHM & 128) phase_scan_b(C, l)); \
        PH(pb + 5, if (PHM & 256) phase_p3(C, l)); \
        PH(pb + 6, if (PHM & 512) phase_p4(C, l)); \
        PH(pb + 7, if (PHM & 1024) phase_p5(C, l)); \
        PH(pb + 8, if (PHM & 2048) { if (OPT_FFN) phase_ffn_elem2(C, l); else phase_ffn_elem(C, l); }); \
        PH(pb + 9, if (PHM & 4096) phase_p7(C, l)); } while (0)
    LAYER(0);
    LAYER(1);
    PH(NPHASE - 1, if (PHM & 2) phase_final(C));
    if (PROBE_MASK != 0u && blockIdx.x == 0) {
        const unsigned long long t1 = __builtin_amdgcn_s_memrealtime();
        while (__builtin_amdgcn_s_memrealtime() - t1 < (unsigned long long)PROBE_MULT * probe_acc) __builtin_amdgcn_s_sleep(32);
    }
}

extern "C" void kernel_launch(void* const* d_in, const int* in_sizes, int n_in, void* d_out, int out_size, void* d_ws, size_t ws_size, hipStream_t stream) {
    static int grid = 0;
    if (grid == 0) {
        if (n_in != N_IN || out_size != (int)O_END || ws_size < WS_END) {
            fprintf(stderr, "kernel_launch: built for %d inputs, %zu outputs, >= %zu bytes of workspace; got n_in %d, out %d, ws %zu; nothing launched\n", (int)N_IN, (size_t)O_END, (size_t)WS_END, n_in, out_size, ws_size); grid = -1; return; }
        int dev = 0, cus = 0, per_cu = 0;
        if (hipGetDevice(&dev) != hipSuccess || hipDeviceGetAttribute(&cus, hipDeviceAttributeMultiprocessorCount, dev) != hipSuccess) { fprintf(stderr, "kernel_launch: device query failed\n"); grid = -1; return; }
        if (hipFuncSetAttribute((const void*)fwd_kernel, hipFuncAttributeMaxDynamicSharedMemorySize, LDS_BYTES) != hipSuccess) { fprintf(stderr, "kernel_launch: hipFuncSetAttribute failed\n"); grid = -1; return; }
        if (hipOccupancyMaxActiveBlocksPerMultiprocessor(&per_cu, (const void*)fwd_kernel, NTHR, LDS_BYTES) != hipSuccess || per_cu < 1) { fprintf(stderr, "kernel_launch: occupancy query says %d blocks per CU\n", per_cu); per_cu = 1; }
        (void)hipGetLastError();
        grid = cus;
        if (grid > 256) grid = 256;
    }
    if (grid < 0) return;
    (void)hipMemsetAsync((char*)d_ws + WS_CTL, 0, CTL_ZERO_BYTES, stream);
    Args a{};
    for (int i = 0; i < N_IN; ++i) a.in[i] = (const GAS float*)d_in[i];
    a.out = (GAS float*)d_out; a.ws = (GAS unsigned char*)d_ws;
#if MK_ONE_LAUNCH
    a.ph_lo = 0; a.ph_hi = NPHASE;
    void* kargs[] = {&a};
    hipError_t e = hipLaunchCooperativeKernel((const void*)fwd_kernel, dim3(grid), dim3(NTHR), kargs, LDS_BYTES, stream);
    if (e != hipSuccess) fprintf(stderr, "kernel_launch: cooperative launch failed: %s (grid %d)\n", hipGetErrorString(e), grid);
#else
    for (int ph = 0; ph < NPHASE; ++ph) { a.ph_lo = ph; a.ph_hi = ph + 1; hipLaunchKernelGGL(fwd_kernel, dim3(grid), dim3(NTHR), LDS_BYTES, stream, a); }
#endif
}
```
